# Optimizing an MI355X kernel written in HIP

```python
import math
import jax, jax.numpy as jnp
from jax import lax
import numpy as np

D_MODEL = 1024
BATCH = 2
SEQ = 8192
DEPTH = 2

N_MIXERS = 2
RMS_EPS = 1e-6
ROPE_THETA = 10000.0
Q_BLOCK = 128
MAX_POS_OFFSET = 4096

DA_HEADS = 8
DA_QK_DIM = 64
DA_V_DIM = 2 * DA_QK_DIM
DA_WIDTH = DA_HEADS * DA_V_DIM

MLA_HEADS = 8
MLA_Q_LORA = 384
MLA_KV_LORA = 256
MLA_NOPE = 128
MLA_ROPE = 64
MLA_V = 128
MLA_WIDTH = MLA_HEADS * MLA_V
MLA_IN = MLA_Q_LORA + MLA_KV_LORA + MLA_ROPE + MLA_WIDTH

kernel_name = "hybrid_diffattn_mla_adaln_encoder"


def _rmsnorm(x, g):
    xf = x.astype(jnp.float32)
    y = xf * lax.rsqrt(jnp.mean(xf * xf, axis=-1, keepdims=True) + RMS_EPS)
    return (y * g.astype(jnp.float32)).astype(x.dtype)


def _rope(x, positions):
    d = x.shape[-1]
    half = d // 2
    inv = ROPE_THETA ** (-jnp.arange(half, dtype=jnp.float32) / half)
    ang = positions.astype(jnp.float32)[..., None] * inv
    cos = jnp.cos(ang)[:, :, None, :]
    sin = jnp.sin(ang)[:, :, None, :]
    xf = x.astype(jnp.float32)
    x1, x2 = xf[..., :half], xf[..., half:]
    out = jnp.concatenate([x1 * cos - x2 * sin, x2 * cos + x1 * sin], axis=-1)
    return out.astype(x.dtype)


def _to_blocks(t):
    b, s = t.shape[:2]
    t = t.reshape((b, s // Q_BLOCK, Q_BLOCK) + t.shape[2:])
    return jnp.moveaxis(t, 1, 0)


def _from_blocks(t):
    t = jnp.moveaxis(t, 0, 1)
    return t.reshape((t.shape[0], t.shape[1] * t.shape[2]) + t.shape[3:])


def _lambda_init(layer_idx):
    return 0.8 - 0.6 * math.exp(-0.3 * layer_idx)


def _modulation(c, ada_w, ada_b):
    mod = jax.nn.silu(c) @ ada_w + ada_b
    shift, scale, gate = jnp.split(mod[:, None, :], 3, axis=-1)
    return shift, scale, gate


def _diff_attention(h, positions, w_in, lam_q1, lam_k1, lam_q2, lam_k2, subln_g, w_out, lambda_init):
    b, s, _ = h.shape
    proj = h @ w_in
    q, k, v, z = jnp.split(proj, [DA_WIDTH, 2 * DA_WIDTH, 3 * DA_WIDTH], axis=-1)
    q = _rope(q.reshape(b, s, 2 * DA_HEADS, DA_QK_DIM), positions)
    k = _rope(k.reshape(b, s, 2 * DA_HEADS, DA_QK_DIM), positions)
    q = q.reshape(b, s, DA_HEADS, 2, DA_QK_DIM)
    k = k.reshape(b, s, DA_HEADS, 2, DA_QK_DIM)
    v = v.reshape(b, s, DA_HEADS, DA_V_DIM)
    f32 = jnp.float32
    lam = (jnp.exp(jnp.sum(lam_q1.astype(f32) * lam_k1.astype(f32)))
           - jnp.exp(jnp.sum(lam_q2.astype(f32) * lam_k2.astype(f32))) + lambda_init)
    scale = DA_QK_DIM ** -0.5

    def block(qb):
        sc = jnp.einsum('bqhcd,bkhcd->bhcqk', qb, k, preferred_element_type=f32) * scale
        p = jax.nn.softmax(sc, axis=-1)
        p = p[:, :, 0] - lam * p[:, :, 1]
        return jnp.einsum('bhqk,bkhd->bqhd', p.astype(v.dtype), v)

    o = _from_blocks(lax.map(block, _to_blocks(q)))
    o = _rmsnorm(o, subln_g) * (1.0 - lambda_init)
    o = o.reshape(b, s, DA_WIDTH) * jax.nn.silu(z)
    return o @ w_out


def _mla(h, positions, w_in, q_a_norm_g, w_q_b, kv_a_norm_g, w_kv_b, w_out):
    b, s, _ = h.shape
    proj = h @ w_in
    q_a, c_kv, k_pe, z = jnp.split(
        proj, [MLA_Q_LORA, MLA_Q_LORA + MLA_KV_LORA, MLA_Q_LORA + MLA_KV_LORA + MLA_ROPE], axis=-1)
    q = (_rmsnorm(q_a, q_a_norm_g) @ w_q_b).reshape(b, s, MLA_HEADS, MLA_NOPE + MLA_ROPE)
    q_nope = q[..., :MLA_NOPE]
    q_pe = _rope(q[..., MLA_NOPE:], positions)
    k_pe = _rope(k_pe[:, :, None, :], positions)[:, :, 0]
    kv = (_rmsnorm(c_kv, kv_a_norm_g) @ w_kv_b).reshape(b, s, MLA_HEADS, MLA_NOPE + MLA_V)
    k_nope, v = kv[..., :MLA_NOPE], kv[..., MLA_NOPE:]
    scale = (MLA_NOPE + MLA_ROPE) ** -0.5
    f32 = jnp.float32

    def block(args):
        qn, qp = args
        sc = (jnp.einsum('bqhd,bkhd->bhqk', qn, k_nope, preferred_element_type=f32)
              + jnp.einsum('bqhr,bkr->bhqk', qp, k_pe, preferred_element_type=f32)) * scale
        p = jax.nn.softmax(sc, axis=-1)
        return jnp.einsum('bhqk,bkhd->bqhd', p.astype(v.dtype), v)

    o = _from_blocks(lax.map(block, (_to_blocks(q_nope), _to_blocks(q_pe))))
    o = o.reshape(b, s, MLA_WIDTH) * jax.nn.silu(z)
    return o @ w_out


def setup_inputs(seed: int = 0) -> dict:
    key = jax.random.key(seed)
    ks = jax.random.split(key, 24)
    f32 = jnp.float32
    nrm = lambda k, shape, fan_in: jax.random.normal(k, shape, f32) * (fan_in ** -0.5)
    gain = lambda k, n: 1.0 + 0.02 * jax.random.normal(k, (n,), f32)
    D = D_MODEL
    x = jax.random.normal(ks[0], (BATCH, SEQ, D), f32)
    c = jax.random.normal(ks[1], (BATCH, D), f32)
    offs = jax.random.randint(ks[2], (BATCH, 1), 0, MAX_POS_OFFSET, dtype=jnp.int32)
    positions = offs + jnp.arange(SEQ, dtype=jnp.int32)[None, :]
    return {
        "x": x,
        "c": c,
        "positions": positions,
        "ada_w0": nrm(ks[3], (D, 3 * D), D),
        "ada_b0": 0.02 * jax.random.normal(ks[4], (3 * D,), f32),
        "norm_g0": gain(ks[5], D),
        "w_in0": nrm(ks[6], (D, 4 * DA_WIDTH), D),
        "lam_q1": 0.1 * jax.random.normal(ks[7], (DA_QK_DIM,), f32),
        "lam_k1": 0.1 * jax.random.normal(ks[8], (DA_QK_DIM,), f32),
        "lam_q2": 0.1 * jax.random.normal(ks[9], (DA_QK_DIM,), f32),
        "lam_k2": 0.1 * jax.random.normal(ks[10], (DA_QK_DIM,), f32),
        "subln_g": gain(ks[11], DA_V_DIM),
        "w_out0": nrm(ks[12], (DA_WIDTH, D), DA_WIDTH),
        "ada_w1": nrm(ks[13], (D, 3 * D), D),
        "ada_b1": 0.02 * jax.random.normal(ks[14], (3 * D,), f32),
        "norm_g1": gain(ks[15], D),
        "w_in1": nrm(ks[16], (D, MLA_IN), D),
        "q_a_norm_g": gain(ks[17], MLA_Q_LORA),
        "w_q_b": nrm(ks[18], (MLA_Q_LORA, MLA_HEADS * (MLA_NOPE + MLA_ROPE)), MLA_Q_LORA),
        "kv_a_norm_g": gain(ks[19], MLA_KV_LORA),
        "w_kv_b": nrm(ks[20], (MLA_KV_LORA, MLA_HEADS * (MLA_NOPE + MLA_V)), MLA_KV_LORA),
        "w_out1": nrm(ks[21], (MLA_WIDTH, D), MLA_WIDTH),
        "final_norm_g": gain(ks[22], D),
    }


def reference(x, c, positions,
              ada_w0, ada_b0, norm_g0, w_in0, lam_q1, lam_k1, lam_q2, lam_k2, subln_g, w_out0,
              ada_w1, ada_b1, norm_g1, w_in1, q_a_norm_g, w_q_b, kv_a_norm_g, w_kv_b, w_out1,
              final_norm_g):
    ada_w = (ada_w0, ada_w1)
    ada_b = (ada_b0, ada_b1)
    norm_g = (norm_g0, norm_g1)
    for i in range(DEPTH):
        shift, scale, gate = _modulation(c, ada_w[i], ada_b[i])
        h = _rmsnorm(x, norm_g[i]) * (1.0 + scale) + shift
        if i % N_MIXERS == 0:
            y = _diff_attention(h, positions, w_in0, lam_q1, lam_k1, lam_q2, lam_k2,
                                subln_g, w_out0, _lambda_init(i))
        else:
            y = _mla(h, positions, w_in1, q_a_norm_g, w_q_b, kv_a_norm_g, w_kv_b, w_out1)
        x = x + gate * y
    return _rmsnorm(x, final_norm_g)
```

```cpp
#include <hip/hip_runtime.h>
#include <hip/hip_bf16.h>
#include <hip/hip_cooperative_groups.h>
#include <cstdio>
#include <cstdint>
namespace cg = cooperative_groups;

#ifndef MK_REP
#define MK_REP 0
#endif
#ifndef MK_COOP
#define MK_COOP 1
#endif

using bf16 = __hip_bfloat16;
using bf16x8 = __attribute__((ext_vector_type(8))) short;
using s16x4  = __attribute__((ext_vector_type(4))) short;
using f32x16 = __attribute__((ext_vector_type(16))) float;
using f32x4  = __attribute__((ext_vector_type(4))) float;
using u32x4  = __attribute__((ext_vector_type(4))) unsigned;
using u32x2  = __attribute__((ext_vector_type(2))) unsigned;

constexpr int TOK = 16384, SEQ = 8192, DM = 1024;
constexpr float RMS_EPS = 1e-6f;
constexpr float QS0 = 0.1803368777036667f;
constexpr float QS1 = 0.10411754995584488f;
constexpr float THR2 = 11.0f;
constexpr size_t MiB = 1u << 20;
constexpr size_t OFF_MOD = 0;
constexpr size_t OFF_LAM = 65536;
constexpr size_t OFF_BAR = 131072;
constexpr size_t OFF_SSQ = 262144;
constexpr size_t OFF_CNT = 524288;
constexpr size_t OFF_BND = 589824;
constexpr size_t OFF_CS = 1 * MiB;
constexpr size_t OFF_WIN0T = 8 * MiB;
constexpr size_t OFF_WOUT0T = 16 * MiB;
constexpr size_t OFF_WIN1T = 18 * MiB;
constexpr size_t OFF_WQBT = 22 * MiB;
constexpr size_t OFF_WKVBT = 24 * MiB;
constexpr size_t OFF_WOUT1T = 25 * MiB;
constexpr size_t OFF_H = 28 * MiB;
constexpr size_t OFF_OG0 = 60 * MiB;
constexpr size_t OFF_P0 = 92 * MiB;
constexpr size_t OFF_Q1 = 60 * MiB;
constexpr size_t OFF_P1 = 108 * MiB;
constexpr size_t OFF_KV1 = 164 * MiB;
constexpr size_t WS_NEED = 228 * MiB;
constexpr int LDS_BYTES = 146 * 1024 + 256;
constexpr int XB_LDS_OFF = 146 * 1024 + 240;

struct Params {
  const float *x, *c; const int* pos;
  const float *ada_w0, *ada_b0, *norm_g0, *w_in0, *lq1, *lk1, *lq2, *lk2, *subln_g, *w_out0;
  const float *ada_w1, *ada_b1, *norm_g1, *w_in1, *qa_g, *w_qb, *kva_g, *w_kvb, *w_out1, *fin_g;
  float* out; char* ws;
};

__device__ const float INVF[32] = {1.000000000e+00f, 7.498942018e-01f, 5.623413324e-01f, 4.216965139e-01f, 3.162277639e-01f, 2.371373773e-01f, 1.778279394e-01f, 1.333521456e-01f, 1.000000015e-01f, 7.498942316e-02f, 5.623413250e-02f, 4.216964915e-02f, 3.162277490e-02f, 2.371373773e-02f, 1.778279431e-02f, 1.333521400e-02f, 9.999999776e-03f, 7.498942316e-03f, 5.623413250e-03f, 4.216964822e-03f, 3.162277630e-03f, 2.371373819e-03f, 1.778279431e-03f, 1.333521446e-03f, 1.000000047e-03f, 7.498941850e-04f, 5.623413017e-04f, 4.216965172e-04f, 3.162277571e-04f, 2.371373703e-04f, 1.778279402e-04f, 1.333521504e-04f};

#define SBAR() __builtin_amdgcn_sched_barrier(0)
__device__ __forceinline__ int crow(int r, int hi) { return (r & 3) + 8 * (r >> 2) + 4 * hi; }
__device__ __forceinline__ unsigned cvtpk(float lo, float hi) {
  unsigned r; asm("v_cvt_pk_bf16_f32 %0, %1, %2" : "=v"(r) : "v"(lo), "v"(hi)); return r;
}
__device__ __forceinline__ int otid() { int t; asm volatile("v_mov_b32 %0, %1" : "=v"(t) : "v"(threadIdx.x)); return t; }
__device__ __forceinline__ float bf2f(unsigned short u) { return __uint_as_float(((unsigned)u) << 16); }
__device__ __forceinline__ float siluf(float v) { return v * __builtin_amdgcn_rcpf(1.f + __expf(-v)); }

__device__ void tr_job(const float* __restrict__ src, int K, int N, int NP, bf16* __restrict__ dst, int idx, const float* __restrict__ gs, float* T) {
  const int tid = otid(), kt = K >> 6, tk = idx % kt, tn = idx / kt, k0 = tk * 64, n0 = tn * 64;
  { const int row = tid >> 3, c8 = (tid & 7) * 8;
    f32x4 a = {0, 0, 0, 0}, b = {0, 0, 0, 0};
    if (n0 < N) { const float* s = src + (size_t)(k0 + row) * N + n0 + c8; a = *(const f32x4*)s; b = *(const f32x4*)(s + 4); }
    float g = gs ? gs[k0 + row] : 1.f;
    float* t = T + row * 65 + c8;
    t[0] = a[0] * g; t[1] = a[1] * g; t[2] = a[2] * g; t[3] = a[3] * g; t[4] = b[0] * g; t[5] = b[1] * g; t[6] = b[2] * g; t[7] = b[3] * g; }
  __syncthreads();
  { const int n = tid >> 3, kc = (tid & 7) * 8; const float* t = T + kc * 65 + n;
    const int c5 = n & 31, np = (n & 32) | (16 * ((c5 >> 2) & 1) + 4 * (c5 >> 3) + (c5 & 3));
    u32x4 w = {cvtpk(t[0], t[65]), cvtpk(t[130], t[195]), cvtpk(t[260], t[325]), cvtpk(t[390], t[455])};
    *(u32x4*)(dst + ((size_t)tk * NP + n0 + np) * 64 + kc) = w; }
  __syncthreads();
}

__device__ __forceinline__ void prep_phase(const Params& p, char* lds) {
  const int tid = otid();
  float* T = (float*)lds;
  float* mod = (float*)(p.ws + OFF_MOD);
  constexpr int J_MOD = 192, J_T0 = 1024, J_T1 = 256, J_T2 = 448, J_T3 = 144, J_T4 = 128, J_T5 = 256, J_CS = 1024;
  constexpr int J_TOTAL = J_MOD + J_T0 + J_T1 + J_T2 + J_T3 + J_T4 + J_T5 + J_CS;
  for (int i = blockIdx.x * 512 + tid; i < 4 * TOK + 128 + 32768; i += gridDim.x * 512) {
    if (i < 4 * TOK) ((float*)(p.ws + OFF_SSQ))[i] = 0.f; else if (i < 4 * TOK + 128) ((unsigned*)(p.ws + OFF_CNT))[i - 4 * TOK] = 0u;
    else ((float*)(p.ws + OFF_BND))[i - 4 * TOK - 128] = 0.f; }
  if (blockIdx.x == gridDim.x - 1 && tid < 64) {
    float a = p.lq1[tid] * p.lk1[tid], b = p.lq2[tid] * p.lk2[tid];
    for (int o = 32; o >= 1; o >>= 1) { a += __shfl_xor(a, o); b += __shfl_xor(b, o); }
    if (tid == 0) *(float*)(p.ws + OFF_LAM) = expf(a) - expf(b) + 0.2f;
  }
  for (int job = blockIdx.x; job < J_TOTAL; job += gridDim.x) {
    int j = job;
    if (j < J_MOD) {
      const int l = j / 96, cgp = j % 96, nl = tid & 31, n = cgp * 32 + nl, kg = tid >> 5;
      const float* W = l ? p.ada_w1 : p.ada_w0; const float* Bv = l ? p.ada_b1 : p.ada_b0;
      float a0 = 0, a1 = 0;
      for (int k = kg * 64; k < kg * 64 + 64; ++k) {
        float w = W[(size_t)k * 3072 + n];
        a0 += siluf(p.c[k]) * w; a1 += siluf(p.c[1024 + k]) * w; }
      T[(kg * 32 + nl) * 2 + 0] = a0; T[(kg * 32 + nl) * 2 + 1] = a1;
      __syncthreads();
      if (tid < 64) { const int b = tid >> 5; float s = 0;
        for (int g = 0; g < 16; ++g) s += T[(g * 32 + nl) * 2 + b];
        mod[(l * 2 + b) * 3072 + n] = s + Bv[n]; }
      __syncthreads();
      continue;
    }
    j -= J_MOD;
    if (j < J_T0) { tr_job(p.w_in0, 1024, 4096, 4096, (bf16*)(p.ws + OFF_WIN0T), j, nullptr, T); continue; } j -= J_T0;
    if (j < J_T1) { tr_job(p.w_out0, 1024, 1024, 1024, (bf16*)(p.ws + OFF_WOUT0T), j, nullptr, T); continue; } j -= J_T1;
    if (j < J_T2) { tr_job(p.w_in1, 1024, 1728, 1792, (bf16*)(p.ws + OFF_WIN1T), j, nullptr, T); continue; } j -= J_T2;
    if (j < J_T3) { tr_job(p.w_qb, 384, 1536, 1536, (bf16*)(p.ws + OFF_WQBT), j, p.qa_g, T); continue; } j -= J_T3;
    if (j < J_T4) { tr_job(p.w_kvb, 256, 2048, 2048, (bf16*)(p.ws + OFF_WKVBT), j, p.kva_g, T); continue; } j -= J_T4;
    if (j < J_T5) { tr_job(p.w_out1, 1024, 1024, 1024, (bf16*)(p.ws + OFF_WOUT1T), j, nullptr, T); continue; } j -= J_T5;
    { const int idx = j * 512 + tid, tok = idx >> 5, i = idx & 31;
      const float ang = (float)p.pos[tok] * INVF[i];
      const double rev = (double)ang * 0.15915494309189535;
      const float fr = (float)(rev - rint(rev));
      float2 cs; cs.x = __builtin_amdgcn_cosf(fr); cs.y = __builtin_amdgcn_sinf(fr);
      ((float2*)(p.ws + OFF_CS))[idx] = cs; }
  }
}

__device__ __forceinline__ void norm_phase(const float* xin, const float* __restrict__ g, const float* __restrict__ mod, bf16* __restrict__ hout, float* fout) {
  const int tid = otid(), lane = tid & 63, wid = tid >> 6;
  for (int row = blockIdx.x * 8 + wid; row < TOK; row += gridDim.x * 8) {
    const float* xr = xin + (size_t)row * DM;
    f32x4 v[4]; float ss = 0;
#pragma unroll
    for (int i = 0; i < 4; ++i) { v[i] = *(const f32x4*)(xr + (i * 64 + lane) * 4); ss += v[i][0] * v[i][0] + v[i][1] * v[i][1] + v[i][2] * v[i][2] + v[i][3] * v[i][3]; }
    for (int o = 32; o >= 1; o >>= 1) ss += __shfl_xor(ss, o);
    const float rstd = rsqrtf(ss * (1.f / DM) + RMS_EPS);
    if (mod) {
      const float* sh = mod + (row >> 13) * 3072; const float* sc = sh + 1024;
#pragma unroll
      for (int i = 0; i < 4; ++i) { const int col = (i * 64 + lane) * 4;
        f32x4 gg = *(const f32x4*)(g + col), s1 = *(const f32x4*)(sc + col), s0 = *(const f32x4*)(sh + col);
        float o0 = v[i][0] * rstd * gg[0] * (1.f + s1[0]) + s0[0], o1 = v[i][1] * rstd * gg[1] * (1.f + s1[1]) + s0[1];
        float o2 = v[i][2] * rstd * gg[2] * (1.f + s1[2]) + s0[2], o3 = v[i][3] * rstd * gg[3] * (1.f + s1[3]) + s0[3];
        u32x2 w = {cvtpk(o0, o1), cvtpk(o2, o3)};
        *(u32x2*)(hout + ((size_t)(i * 4 + (lane >> 4)) * TOK + row) * 64 + (lane & 15) * 4) = w; }
    } else {
#pragma unroll
      for (int i = 0; i < 4; ++i) { const int col = (i * 64 + lane) * 4;
        f32x4 gg = *(const f32x4*)(g + col);
        f32x4 o = {v[i][0] * rstd * gg[0], v[i][1] * rstd * gg[1], v[i][2] * rstd * gg[2], v[i][3] * rstd * gg[3]};
        *(f32x4*)(fout + (size_t)row * DM + col) = o; }
    }
  }
}

enum { G_PROJ0 = 0, G_OUT0 = 1, G_PROJ1 = 2, G_Q = 3, G_KV = 4, G_OUT1 = 5 };
enum { E_PLAIN = 0, E_ROPE = 1, E_SILU = 2, E_SKIP = 3 };
#define GSWZ(row, ch) ((row) * 128 + ((((ch) ^ ((row) >> 1)) & 7) << 4))

#define RAW_BARRIER() do { asm volatile("s_waitcnt lgkmcnt(0)" ::: "memory"); __builtin_amdgcn_s_barrier(); } while (0)
__device__ __forceinline__ void gemm_tile(const Params& p, int kind, const bf16* __restrict__ A, int lda, const bf16* __restrict__ Bt, int K, int ntn, int tm, int tn, char* lds) {
  const int tid = otid(), wid = __builtin_amdgcn_readfirstlane(tid >> 6), lane = tid & 63, r32 = lane & 31, hi = lane >> 5, wr = wid >> 1, wc = wid & 1;
  char* As = lds; char* Bs = lds + 65536; float* rs = (float*)(lds + 131072);
  const bool aslab = lda == 0;
  const size_t a_rs = aslab ? 64 : lda, a_ks = aslab ? (size_t)TOK * 64 : 64, b_ks = (size_t)ntn * 256 * 64;
  const bf16* Ag = A + (size_t)(tm * 256) * a_rs; const bf16* Bg = Bt + (size_t)(tn * 256) * 64;
  __syncthreads();
  if (kind == G_Q || kind == G_KV) {
    if (tid < 256) rs[tid] = rsqrtf(((const float*)(p.ws + OFF_SSQ))[(kind == G_Q ? 2 : 3) * TOK + tm * 256 + tid] / (float)K + RMS_EPS);
  }
  f32x16 acc[2][4] = {};
  const int lch = (lane & 7) ^ ((wid * 4 + (lane >> 4)) & 7);
  const bf16* Ap = Ag + (size_t)(wid * 8 + (lane >> 3)) * a_rs + lch * 8; const bf16* Bp = Bg + (size_t)(wid * 8 + (lane >> 3)) * 64 + lch * 8;
#define GLDS(st, kt) do { _Pragma("unroll") for (int i = 0; i < 4; ++i) \
      __builtin_amdgcn_global_load_lds((const unsigned*)(Ap + (size_t)(i * 64) * a_rs + (kt) * a_ks), (unsigned*)(As + (st) * 32768 + (i * 8 + wid) * 1024), 16, 0, 0); \
    _Pragma("unroll") for (int i = 0; i < 4; ++i) \
      __builtin_amdgcn_global_load_lds((const unsigned*)(Bp + (size_t)(i * 64) * 64 + (kt) * b_ks), (unsigned*)(Bs + (st) * 32768 + (i * 8 + wid) * 1024), 16, 0, 0); } while (0)
  const int nk = K >> 6;
  const int ar0 = wr * 64 + r32, br0 = wc * 128 + r32;
  bf16x8 fa[2], fb[4];
#define LDFR(ks) do { const int ch = (ks) * 2 + hi; \
    _Pragma("unroll") for (int mi = 0; mi < 2; ++mi) fa[mi] = *(const bf16x8*)(Ab + GSWZ(ar0 + mi * 32, ch)); \
    _Pragma("unroll") for (int nj = 0; nj < 4; ++nj) fb[nj] = *(const bf16x8*)(Bb + GSWZ(br0 + nj * 32, ch)); } while (0)
#define GPIECE(st, kt, i) do { if ((i) < 4) __builtin_amdgcn_global_load_lds((const unsigned*)(Ap + (size_t)((i) * 64) * a_rs + (kt) * a_ks), (unsigned*)(As + (st) * 32768 + ((i) * 8 + wid) * 1024), 16, 0, 0); \
    else __builtin_amdgcn_global_load_lds((const unsigned*)(Bp + (size_t)(((i) - 4) * 64) * 64 + (kt) * b_ks), (unsigned*)(Bs + (st) * 32768 + (((i) - 4) * 8 + wid) * 1024), 16, 0, 0); } while (0)
#define BAR() do { asm volatile("" ::: "memory"); __builtin_amdgcn_s_barrier(); asm volatile("" ::: "memory"); } while (0)
  GLDS(0, 0);
  asm volatile("s_waitcnt vmcnt(0)" ::: "memory"); BAR();
  if (wid >= 4) BAR();
  for (int kt = 0; kt < nk; ++kt) {
    const bool more = kt + 1 < nk; const int st1 = (kt + 1) & 1;
    const char* Ab = As + (kt & 1) * 32768; const char* Bb = Bs + (kt & 1) * 32768;
#pragma unroll
    for (int ks = 0; ks < 4; ++ks) {
      LDFR(ks);
      if (more) { if (ks == 0) { GPIECE(st1, kt + 1, 0); GPIECE(st1, kt + 1, 1); GPIECE(st1, kt + 1, 4); GPIECE(st1, kt + 1, 5); }
                  if (ks == 1) { GPIECE(st1, kt + 1, 2); GPIECE(st1, kt + 1, 3); GPIECE(st1, kt + 1, 6); GPIECE(st1, kt + 1, 7); } }
      if (ks == 3) asm volatile("s_waitcnt vmcnt(0)" ::: "memory");
      SBAR(); BAR();
      asm volatile("s_waitcnt lgkmcnt(0)" ::: "memory"); SBAR();
      __builtin_amdgcn_s_setprio(3);
#pragma unroll
      for (int mi = 0; mi < 2; ++mi)
#pragma unroll
        for (int nj = 0; nj < 4; ++nj) acc[mi][nj] = __builtin_amdgcn_mfma_f32_32x32x16_bf16(fb[nj], fa[mi], acc[mi][nj], 0, 0, 0);
      __builtin_amdgcn_s_setprio(0);
      SBAR(); BAR();
    }
  }
  if (wid < 4) BAR();
#undef BAR
#undef GLDS
#undef LDFR
#undef GPIECE
  int opq; asm volatile("v_mov_b32 %0, 0" : "=v"(opq));
  const int rowb = tm * 256 + wr * 64;
  const float* cst = (const float*)(p.ws + OFF_CS);
#define RG(e, t) ((e) < 4 ? 4 * (t) + (e) : 8 + 4 * (t) + (e) - 4)
#pragma unroll
  for (int q = 0; q < 2; ++q) {
    const int n64 = tn * 4 + wc * 2 + q;
    if (kind == G_OUT0 || kind == G_OUT1) {
      continue;
    }
    int mode = E_PLAIN, ldc; float mul = 1.f; bf16* dst;
    if (kind == G_PROJ0) { const int sec = n64 >> 4; mode = sec < 2 ? E_ROPE : (sec == 3 ? E_SILU : E_PLAIN); mul = sec == 0 ? QS0 : 1.f; dst = (bf16*)(p.ws + OFF_P0); ldc = 4096; }
    else if (kind == G_PROJ1) { mode = n64 < 10 ? E_PLAIN : (n64 == 10 ? E_ROPE : (n64 < 27 ? E_SILU : E_SKIP)); dst = (bf16*)(p.ws + OFF_P1); ldc = 1792; }
    else if (kind == G_Q) { mode = (n64 % 3 == 2) ? E_ROPE : E_PLAIN; mul = QS1; dst = (bf16*)(p.ws + OFF_Q1); ldc = 1536; }
    else { dst = (bf16*)(p.ws + OFF_KV1); ldc = 2048; }
    if (mode == E_SKIP) continue;
    const bool use_rs = (kind == G_Q || kind == G_KV);
    int bcat = -1, bsl = 0;
    if (kind == G_PROJ0) { if (n64 < 32) { bcat = n64 >> 4; bsl = n64 & 15; } }
    else if (kind == G_PROJ1) { if (n64 == 10) { bcat = 3; bsl = 31; } }
    else if (kind == G_Q) { bcat = 2; bsl = n64; }
    else if (kind == G_KV) { if ((n64 & 3) < 2) { bcat = 3; bsl = n64; } }
    const bool want_ss = (kind == G_PROJ1 && n64 < 10) || bcat >= 0;
    float ssacc[2] = {0.f, 0.f};
#pragma unroll
    for (int mi = 0; mi < 2; ++mi) {
      const int rl = wr * 64 + mi * 32 + r32, row = tm * 256 + rl;
      const float sm = (use_rs ? rs[rl] : 1.f) * mul;
      bf16* drow = dst + (size_t)row * ldc + n64 * 64 + hi * 8;
#pragma unroll
      for (int t = 0; t < 2; ++t) {
        float v0[8], v1[8];
#pragma unroll
        for (int e = 0; e < 8; ++e) { v0[e] = acc[mi][2 * q][RG(e, t)] * sm; v1[e] = acc[mi][2 * q + 1][RG(e, t)] * sm; }
        if (mode == E_ROPE) {
          const float* cp = cst + ((size_t)row * 32 + t * 16 + hi * 8) * 2;
#pragma unroll
          for (int e2 = 0; e2 < 4; ++e2) { const f32x4 c4 = *(const f32x4*)(cp + e2 * 4);
            { const int e = 2 * e2; const float o0 = v0[e] * c4[0] - v1[e] * c4[1], o1 = v1[e] * c4[0] + v0[e] * c4[1]; v0[e] = o0; v1[e] = o1; }
            { const int e = 2 * e2 + 1; const float o0 = v0[e] * c4[2] - v1[e] * c4[3], o1 = v1[e] * c4[2] + v0[e] * c4[3]; v0[e] = o0; v1[e] = o1; } }
        } else if (mode == E_SILU) {
#pragma unroll
          for (int e = 0; e < 8; ++e) { v0[e] = siluf(v0[e]); v1[e] = siluf(v1[e]); }
        }
        if (want_ss) {
#pragma unroll
          for (int e = 0; e < 8; ++e) ssacc[mi] += v0[e] * v0[e] + v1[e] * v1[e]; }
        u32x4 w0 = {cvtpk(v0[0], v0[1]), cvtpk(v0[2], v0[3]), cvtpk(v0[4], v0[5]), cvtpk(v0[6], v0[7])};
        u32x4 w1 = {cvtpk(v1[0], v1[1]), cvtpk(v1[2], v1[3]), cvtpk(v1[4], v1[5]), cvtpk(v1[6], v1[7])};
        *(u32x4*)(drow + t * 16) = w0; *(u32x4*)(drow + 32 + t * 16) = w1;
      }
    }
    if (bcat >= 0) {
      float m = fmaxf(ssacc[0] + __shfl_xor(ssacc[0], 32), ssacc[1] + __shfl_xor(ssacc[1], 32));
      m = fmaxf(m, __shfl_xor(m, 1)); m = fmaxf(m, __shfl_xor(m, 2)); m = fmaxf(m, __shfl_xor(m, 4)); m = fmaxf(m, __shfl_xor(m, 8)); m = fmaxf(m, __shfl_xor(m, 16));
      if (lane == 0) ((float*)(p.ws + OFF_BND))[(bcat * 256 + (rowb >> 6)) * 32 + bsl] = m;
    }
    if (kind == G_PROJ1 && n64 < 10) {
      float* sq = (float*)(p.ws + OFF_SSQ) + (n64 < 6 ? 2 : 3) * TOK + rowb;
#pragma unroll
      for (int mi = 0; mi < 2; ++mi) { float ss = ssacc[mi]; ss += __shfl_xor(ss, 32);
        if (hi == 0) __hip_atomic_fetch_add(sq + mi * 32 + r32, ss, __ATOMIC_RELAXED, __HIP_MEMORY_SCOPE_AGENT); }
    }
  }
  if (kind == G_OUT0 || kind == G_OUT1) {
    const float* xo = kind == G_OUT0 ? p.x : p.out;
    const int colb = tn * 256 + wc * 128 + hi * 8;
    const float* gate = (const float*)(p.ws + OFF_MOD) + (kind == G_OUT0 ? 0 : 2) * 3072 + (rowb >> 13) * 3072 + 2048 + colb;
#pragma unroll
    for (int mi = 0; mi < 2; ++mi) {
      const size_t ro = (size_t)(rowb + mi * 32 + r32) * DM + colb;
      const float* xr = xo + ro; float* orow = p.out + ro;
#pragma unroll
      for (int nj = 0; nj < 4; ++nj) {
#pragma unroll
        for (int t = 0; t < 2; ++t) { const int co = nj * 32 + t * 16;
          const f32x4 ga = *(const f32x4*)(gate + co), gb = *(const f32x4*)(gate + co + 4);
          const f32x4 xa = *(const f32x4*)(xr + co), xb = *(const f32x4*)(xr + co + 4);
          f32x4 ra, rb;
#pragma unroll
          for (int e = 0; e < 4; ++e) { ra[e] = xa[e] + ga[e] * acc[mi][nj][RG(e, t)]; rb[e] = xb[e] + gb[e] * acc[mi][nj][RG(e + 4, t)];
            acc[mi][nj][RG(e, t)] = ra[e]; acc[mi][nj][RG(e + 4, t)] = rb[e]; }
          if (kind == G_OUT0 || opq != 0) { *(f32x4*)(orow + co) = ra; *(f32x4*)(orow + co + 4) = rb; } }
        SBAR(); }
    }
    float* ssq = (float*)(p.ws + OFF_SSQ) + (kind == G_OUT0 ? 0 : 1) * TOK;
    unsigned* cnt = (unsigned*)(p.ws + OFF_CNT) + (kind == G_OUT0 ? 0 : 64) + tm;
#pragma unroll
    for (int mi = 0; mi < 2; ++mi) { float ss = 0;
#pragma unroll
      for (int nj = 0; nj < 4; ++nj)
#pragma unroll
        for (int r = 0; r < 16; ++r) ss += acc[mi][nj][r] * acc[mi][nj][r];
      ss += __shfl_xor(ss, 32);
      if (hi == 0) __hip_atomic_fetch_add(ssq + rowb + mi * 32 + r32, ss, __ATOMIC_RELAXED, __HIP_MEMORY_SCOPE_AGENT); }
    asm volatile("s_waitcnt vmcnt(0)" ::: "memory");
    __syncthreads();
    if (tid == 0) { __hip_atomic_fetch_add(cnt, 1u, __ATOMIC_RELAXED, __HIP_MEMORY_SCOPE_AGENT);
      while (__hip_atomic_load(cnt, __ATOMIC_RELAXED, __HIP_MEMORY_SCOPE_AGENT) < 4u) __builtin_amdgcn_s_sleep(1); }
    __syncthreads();
    const float* gvec = (kind == G_OUT0 ? p.norm_g1 : p.fin_g) + colb;
    const float* modl = (const float*)(p.ws + OFF_MOD) + 2 * 3072 + (rowb >> 13) * 3072 + colb;
#pragma unroll
    for (int mi = 0; mi < 2; ++mi) {
      const int row = rowb + mi * 32 + r32;
      const float rstd = rsqrtf(__hip_atomic_load(ssq + row, __ATOMIC_RELAXED, __HIP_MEMORY_SCOPE_AGENT) * (1.f / DM) + RMS_EPS);
      float* orow = p.out + (size_t)row * DM + colb;
#pragma unroll
      for (int nj = 0; nj < 4; ++nj) {
        bf16* hrow = (bf16*)(p.ws + OFF_H) + ((size_t)(tn * 4 + wc * 2 + (nj >> 1)) * TOK + row) * 64 + hi * 8 + (nj & 1) * 32;
#pragma unroll
        for (int t = 0; t < 2; ++t) { const int co = nj * 32 + t * 16;
          const f32x4 ga = *(const f32x4*)(gvec + co), gb = *(const f32x4*)(gvec + co + 4);
          float v[8];
#pragma unroll
          for (int e = 0; e < 4; ++e) { v[e] = acc[mi][nj][RG(e, t)] * rstd * ga[e]; v[e + 4] = acc[mi][nj][RG(e + 4, t)] * rstd * gb[e]; }
          if (kind == G_OUT0) {
            const f32x4 sa = *(const f32x4*)(modl + 1024 + co), sb = *(const f32x4*)(modl + 1024 + co + 4), ha = *(const f32x4*)(modl + co), hb = *(const f32x4*)(modl + co + 4);
#pragma unroll
            for (int e = 0; e < 4; ++e) { v[e] = v[e] * (1.f + sa[e]) + ha[e]; v[e + 4] = v[e + 4] * (1.f + sb[e]) + hb[e]; }
            u32x4 w = {cvtpk(v[0], v[1]), cvtpk(v[2], v[3]), cvtpk(v[4], v[5]), cvtpk(v[6], v[7])};
            *(u32x4*)(hrow + t * 16) = w;
          } else {
            f32x4 oa = {v[0], v[1], v[2], v[3]}, ob = {v[4], v[5], v[6], v[7]};
            *(f32x4*)(orow + co) = oa; *(f32x4*)(orow + co + 4) = ob;
          } }
        SBAR(); }
    }
  }
#undef RG
}

__device__ __forceinline__ void gemm_phase(const Params& p, int kind, const bf16* A, int lda, const bf16* Bt, int K, int ntn, char* lds) {
  const int x = blockIdx.x & 7, slot = blockIdx.x >> 3, nslot = gridDim.x >> 3;
  if (kind == G_KV && nslot == 32) {
    if (slot < 16) { const int w = 48 + slot; gemm_tile(p, kind, A, lda, Bt, K, ntn, x * 8 + (w & 7), w >> 3, lds); }
    else for (int i = 0; i < 3; ++i) { const int w = (slot - 16) * 3 + i; gemm_tile(p, kind, A, lda, Bt, K, ntn, x * 8 + (w & 7), w >> 3, lds); }
    return; }
  for (int w = slot; w < 8 * ntn; w += nslot) gemm_tile(p, kind, A, lda, Bt, K, ntn, x * 8 + (w & 7), w >> 3, lds);
}

#define KSWZ(row, colB) ((row) * 256 + ((colB) ^ (((row) & 7) << 4)))
__device__ __forceinline__ void partialSM(f32x16& p0, f32x16& p1, float& m_reg, float& mn, float& alpha, bool fast) {
  if (fast) {
    alpha = 1.f; mn = 0.f;
#pragma unroll
    for (int r = 0; r < 16; ++r) p0[r] = __builtin_amdgcn_exp2f(p0[r]);
    return;
  }
  float pmax = p0[0];
#pragma unroll
  for (int r = 1; r < 16; ++r) pmax = fmaxf(pmax, p0[r]);
#pragma unroll
  for (int r = 0; r < 16; ++r) pmax = fmaxf(pmax, p1[r]);
  { auto rr = __builtin_amdgcn_permlane32_swap(__float_as_uint(pmax), __float_as_uint(pmax), false, false);
    pmax = fmaxf(__uint_as_float(rr[0]), __uint_as_float(rr[1])); }
  if (__builtin_expect(__all(pmax - m_reg <= THR2), 1)) { mn = m_reg; alpha = 1.f; }
  else { mn = fmaxf(m_reg, pmax); alpha = __builtin_amdgcn_exp2f(m_reg - mn); m_reg = mn; }
#pragma unroll
  for (int r = 0; r < 16; ++r) p0[r] -= mn;
#pragma unroll
  for (int r = 0; r < 16; ++r) p1[r] -= mn;
#pragma unroll
  for (int r = 0; r < 16; ++r) p0[r] = __builtin_amdgcn_exp2f(p0[r]);
}
__device__ __forceinline__ void finishSM(f32x16& p0, f32x16& p1, float alpha, float& l_reg, bf16x8& pa0, bf16x8& pa1, bf16x8& pa2, bf16x8& pa3) {
#pragma unroll
  for (int r = 0; r < 16; ++r) p1[r] = __builtin_amdgcn_exp2f(p1[r]);
  float ps = 0;
#pragma unroll
  for (int r = 0; r < 16; ++r) ps += p0[r];
#pragma unroll
  for (int r = 0; r < 16; ++r) ps += p1[r];
  { auto rr = __builtin_amdgcn_permlane32_swap(__float_as_uint(ps), __float_as_uint(ps), false, false);
    ps = __uint_as_float(rr[0]) + __uint_as_float(rr[1]); }
  l_reg = l_reg * alpha + ps;
#define PK4(P, BASE, OUT) do { unsigned a0 = cvtpk(P[BASE + 0], P[BASE + 1]), a1 = cvtpk(P[BASE + 2], P[BASE + 3]);   \
    unsigned b0 = cvtpk(P[BASE + 4], P[BASE + 5]), b1 = cvtpk(P[BASE + 6], P[BASE + 7]);                              \
    auto r0 = __builtin_amdgcn_permlane32_swap(a0, b0, false, false); auto r1 = __builtin_amdgcn_permlane32_swap(a1, b1, false, false); \
    u32x4 w = {r0[0], r1[0], r0[1], r1[1]}; OUT = *reinterpret_cast<bf16x8*>(&w); } while (0)
  PK4(p0, 0, pa0); PK4(p0, 8, pa1); PK4(p1, 0, pa2); PK4(p1, 8, pa3);
#undef PK4
}
template <int MODE>
__device__ __forceinline__ void qkt(f32x16& p0, f32x16& p1, const char* Ks, const char* Rs, const bf16x8* qr, const char* qp, int r32, int hi, int kc0) {
  p0 = f32x16{}; p1 = f32x16{};
  constexpr int NN = MODE == 0 ? 4 : 8;
#pragma unroll
  for (int d0 = 0; d0 < NN; ++d0) { const int cb = kc0 + (d0 * 16 + hi * 8) * 2;
    bf16x8 b0 = *reinterpret_cast<const bf16x8*>(Ks + KSWZ(r32, cb));
    bf16x8 b1 = *reinterpret_cast<const bf16x8*>(Ks + KSWZ(32 + r32, cb));
    p0 = __builtin_amdgcn_mfma_f32_32x32x16_bf16(b0, qr[d0], p0, 0, 0, 0);
    p1 = __builtin_amdgcn_mfma_f32_32x32x16_bf16(b1, qr[d0], p1, 0, 0, 0); }
  if constexpr (MODE == 1) {
#pragma unroll
    for (int d0 = 0; d0 < 4; ++d0) { const int ch = d0 * 2 + hi;
      bf16x8 q = *reinterpret_cast<const bf16x8*>(qp + d0 * 8192);
      bf16x8 b0 = *reinterpret_cast<const bf16x8*>(Rs + GSWZ(r32, ch));
      bf16x8 b1 = *reinterpret_cast<const bf16x8*>(Rs + GSWZ(32 + r32, ch));
      p0 = __builtin_amdgcn_mfma_f32_32x32x16_bf16(b0, q, p0, 0, 0, 0);
      p1 = __builtin_amdgcn_mfma_f32_32x32x16_bf16(b1, q, p1, 0, 0, 0); }
  }
}
__device__ __forceinline__ int v_st(int k, int c) { const int kk = (k & ~0xC) | ((k & 4) << 1) | ((k & 8) >> 1); return ((kk >> 3) * 4 + (c >> 5)) * 512 + ((kk & 7) * 32 + (c & 31)) * 2; }
__device__ __forceinline__ int v_rd_base(int lane) { return ((lane & 3) << 3) | (((lane >> 2) & 3) << 6) | (((lane >> 4) & 1) << 5) | (((lane >> 5) & 1) << 8); }
constexpr int v_rd_off(int d0, int ks, int half) { return d0 * 512 + ks * 4096 + half * 2048; }
template <int OFF> __device__ __forceinline__ s16x4 tr_read(int vb) {
  s16x4 r; asm volatile("ds_read_b64_tr_b16 %0, %1 offset:%2" : "=&v"(r) : "v"(vb), "i"(OFF)); return r;
}
template <int D0> __device__ __forceinline__ void pv_one(f32x16& od, int vb, bf16x8 pa0, bf16x8 pa1, bf16x8 pa2, bf16x8 pa3) {
  s16x4 l0 = tr_read<v_rd_off(D0, 0, 0)>(vb), h0 = tr_read<v_rd_off(D0, 0, 1)>(vb), l1 = tr_read<v_rd_off(D0, 1, 0)>(vb), h1 = tr_read<v_rd_off(D0, 1, 1)>(vb);
  s16x4 l2 = tr_read<v_rd_off(D0, 2, 0)>(vb), h2 = tr_read<v_rd_off(D0, 2, 1)>(vb), l3 = tr_read<v_rd_off(D0, 3, 0)>(vb), h3 = tr_read<v_rd_off(D0, 3, 1)>(vb);
  asm volatile("s_waitcnt lgkmcnt(0)" : "+v"(l0), "+v"(h0), "+v"(l1), "+v"(h1), "+v"(l2), "+v"(h2), "+v"(l3), "+v"(h3) :: "memory");
#define PK(L, H) (bf16x8){L[0], L[1], L[2], L[3], H[0], H[1], H[2], H[3]}
  od = __builtin_amdgcn_mfma_f32_32x32x16_bf16(pa0, PK(l0, h0), od, 0, 0, 0);
  od = __builtin_amdgcn_mfma_f32_32x32x16_bf16(pa1, PK(l1, h1), od, 0, 0, 0);
  od = __builtin_amdgcn_mfma_f32_32x32x16_bf16(pa2, PK(l2, h2), od, 0, 0, 0);
  od = __builtin_amdgcn_mfma_f32_32x32x16_bf16(pa3, PK(l3, h3), od, 0, 0, 0);
#undef PK
}
__device__ __forceinline__ void pv_d0(f32x16* o, int vb, bf16x8 pa0, bf16x8 pa1, bf16x8 pa2, bf16x8 pa3) {
  pv_one<0>(o[0], vb, pa0, pa1, pa2, pa3); pv_one<1>(o[1], vb, pa0, pa1, pa2, pa3); pv_one<2>(o[2], vb, pa0, pa1, pa2, pa3); pv_one<3>(o[3], vb, pa0, pa1, pa2, pa3);
}

template <int MODE, bool FAST>
__device__ __forceinline__ void attn_tile(const Params& p, int tile, char* lds) {
  constexpr bool fast = FAST;
  constexpr int SHM_V = 16384, SHM_K = 16384, SHM_R = 8192, KVBLK = 64;
  const int tid = otid(), wid = __builtin_amdgcn_readfirstlane(tid >> 6), lane = tid & 63, r32 = lane & 31, hi = lane >> 5;
  char* V_lds = lds; char* K_lds = lds + (MODE == 0 ? 5 : 3) * SHM_V; char* R_lds = K_lds + 2 * SHM_K;
  float* wsf = (float*)(lds + (MODE == 0 ? 147456 : 98304)) + wid * 64; float* li_l = wsf; float* al_l = wsf + 32;
  const bf16 *Qw, *Kh, *Vh, *Rh = nullptr; int tok0, h, kc0 = 0;
  constexpr int LDK = MODE == 0 ? 4096 : 2048, LDR = 1792;
  if constexpr (MODE == 0) {
    const int qb = tile & 63; h = (tile >> 6) & 7; const int b = tile >> 9, c = wid & 1, g = wid >> 1;
    tok0 = b * SEQ + qb * 128 + g * 32; kc0 = c * 128;
    const bf16* P0 = (const bf16*)(p.ws + OFF_P0);
    Qw = P0 + (size_t)(tok0 + r32) * 4096 + h * 128 + c * 64 + hi * 8;
    Kh = P0 + (size_t)(b * SEQ) * 4096 + 1024 + h * 128; Vh = Kh + 1024;
  } else {
    const int qb = tile & 31; h = (tile >> 5) & 7; const int b = tile >> 8;
    tok0 = b * SEQ + qb * 256 + wid * 32;
    Qw = (const bf16*)(p.ws + OFF_Q1) + (size_t)(tok0 + r32) * 1536 + h * 192 + hi * 8;
    Kh = (const bf16*)(p.ws + OFF_KV1) + (size_t)(b * SEQ) * 2048 + h * 256; Vh = Kh + 128;
    Rh = (const bf16*)(p.ws + OFF_P1) + (size_t)(b * SEQ) * 1792 + 640;
  }
  __syncthreads();
  const int krow = 4 * wid + (lane >> 4), klc = (lane & 15) ^ (krow & 7);
  const bf16* kp = Kh + (size_t)krow * LDK + klc * 8;
  const int vkk = (wid >> 1) * 8 + ((lane & 31) >> 2), vk = (vkk & ~0xC) | ((vkk & 4) << 1) | ((vkk & 8) >> 1);
  const bf16* vp = Vh + (size_t)vk * LDK + (2 * (wid & 1) + (lane >> 5)) * 32 + (lane & 3) * 8;
  const int rrow = 8 * wid + (lane >> 3);
  const bf16* rp = MODE == 1 ? Rh + (size_t)rrow * LDR + (((lane & 7) ^ ((rrow >> 1) & 7)) * 8) : nullptr;
#define GL(src, dst) __builtin_amdgcn_global_load_lds((const unsigned*)(src), (unsigned*)(dst), 16, 0, 0)
#define DMA(j, kb, vbi) do { const size_t ko = (size_t)(j) * KVBLK * LDK; \
    GL(kp + ko, K_lds + (kb) * SHM_K + wid * 1024); GL(kp + ko + 32 * LDK, K_lds + (kb) * SHM_K + (wid + 8) * 1024); \
    GL(vp + ko, V_lds + (vbi) * SHM_V + wid * 1024); GL(vp + ko + 32 * LDK, V_lds + (vbi) * SHM_V + (wid + 8) * 1024); \
    if constexpr (MODE == 1) GL(rp + (size_t)(j) * KVBLK * LDR, R_lds + (kb) * SHM_R + wid * 1024); } while (0)
#define TOPSYNC() do { asm volatile("s_waitcnt vmcnt(0)" ::: "memory"); RAW_BARRIER(); } while (0)
#define DMAK1(t, sl) do { const size_t ko = (size_t)(t) * KVBLK * LDK; GL(kp + ko, K_lds + (sl) * SHM_K + wid * 1024); GL(kp + ko + 32 * LDK, K_lds + (sl) * SHM_K + (wid + 8) * 1024); } while (0)
#define DMAV1(t, sl) do { const size_t ko = (size_t)(t) * KVBLK * LDK; GL(vp + ko, V_lds + (sl) * SHM_V + wid * 1024); GL(vp + ko + 32 * LDK, V_lds + (sl) * SHM_V + (wid + 8) * 1024); } while (0)
  if constexpr (MODE == 0) { DMAK1(0, 0); DMAV1(0, 0); DMAK1(1, 1); DMAV1(1, 1); DMAK1(2, 2); DMAV1(2, 2); DMAK1(3, 3); DMAV1(3, 3); }
  else { DMA(0, 0, 0); DMA(1, 1, 1); }
  constexpr int NQR = MODE == 0 ? 4 : 8;
  float m_reg = -1e30f, l_reg = 0; f32x16 o[4] = {}; bf16x8 qr[NQR];
#pragma unroll
  for (int d0 = 0; d0 < NQR; ++d0) qr[d0] = *(const bf16x8*)(Qw + d0 * 16);
  char* qp = lds + 100352 + tid * 16;
  if constexpr (MODE == 1) {
#pragma unroll
    for (int f = 0; f < 4; ++f) *(bf16x8*)(qp + f * 8192) = *(const bf16x8*)(Qw + (8 + f) * 16);
  }
  const int vb0 = (int)(uintptr_t)V_lds + v_rd_base(lane);
#define RESC(a) do { if constexpr (!FAST) if (__any((a) < 1.f)) { if (hi == 0) al_l[r32] = (a); asm volatile("s_waitcnt lgkmcnt(0)" ::: "memory"); \
    _Pragma("unroll") for (int d = 0; d < 4; ++d) _Pragma("unroll") for (int r = 0; r < 16; ++r) o[d][r] *= al_l[crow(r, hi)]; } } while (0)
  f32x16 pA0, pA1, pB0, pB1; float mnA, mnB, alA, alB; bf16x8 pa0, pa1, pa2, pa3; constexpr int NT = SEQ / KVBLK;
  if (__builtin_amdgcn_readfirstlane(tid) >= 256) __builtin_amdgcn_s_setprio(1);
  if constexpr (MODE == 0) {
    TOPSYNC();
    qkt<MODE>(pA0, pA1, K_lds, R_lds, qr, qp, r32, hi, kc0); partialSM(pA0, pA1, m_reg, mnA, alA, fast);
    int vpv = 0;
    for (int t = 1; t + 1 < NT; t += 2) {
      SBAR(); qkt<MODE>(pB0, pB1, K_lds + (t & 3) * SHM_K, R_lds, qr, qp, r32, hi, kc0);
      finishSM(pA0, pA1, alA, l_reg, pa0, pa1, pa2, pa3); SBAR();
      pv_d0(o, vb0 + vpv * SHM_V, pa0, pa1, pa2, pa3); partialSM(pB0, pB1, m_reg, mnB, alB, fast);
      RESC(alB);
      vpv = vpv == 4 ? 0 : vpv + 1;
      TOPSYNC();
      SBAR(); qkt<MODE>(pA0, pA1, K_lds + ((t + 1) & 3) * SHM_K, R_lds, qr, qp, r32, hi, kc0);
      finishSM(pB0, pB1, alB, l_reg, pa0, pa1, pa2, pa3); SBAR();
      if (t + 3 < NT) { const int v3 = vpv + 3 >= 5 ? vpv - 2 : vpv + 3, v4 = vpv + 4 >= 5 ? vpv - 1 : vpv + 4;
        DMAK1(t + 3, (t + 3) & 3); DMAV1(t + 3, v3); DMAK1(t + 4, (t + 4) & 3); DMAV1(t + 4, v4); } SBAR();
      pv_d0(o, vb0 + vpv * SHM_V, pa0, pa1, pa2, pa3); partialSM(pA0, pA1, m_reg, mnA, alA, fast);
      RESC(alA);
      vpv = vpv == 4 ? 0 : vpv + 1;
    }
    SBAR(); qkt<MODE>(pB0, pB1, K_lds + ((NT - 1) & 3) * SHM_K, R_lds, qr, qp, r32, hi, kc0);
    finishSM(pA0, pA1, alA, l_reg, pa0, pa1, pa2, pa3); SBAR();
    pv_d0(o, vb0 + vpv * SHM_V, pa0, pa1, pa2, pa3); partialSM(pB0, pB1, m_reg, mnB, alB, fast);
    RESC(alB);
    vpv = vpv == 4 ? 0 : vpv + 1;
    finishSM(pB0, pB1, alB, l_reg, pa0, pa1, pa2, pa3); SBAR();
    pv_d0(o, vb0 + vpv * SHM_V, pa0, pa1, pa2, pa3);
  } else {
  TOPSYNC();
  qkt<MODE>(pA0, pA1, K_lds, R_lds, qr, qp, r32, hi, kc0); partialSM(pA0, pA1, m_reg, mnA, alA, fast);
  int vpv = 0;
  for (int j = 1; j + 1 < NT; j += 2) {
    TOPSYNC();
    SBAR(); qkt<MODE>(pB0, pB1, K_lds + SHM_K, R_lds + SHM_R, qr, qp, r32, hi, kc0);
    finishSM(pA0, pA1, alA, l_reg, pa0, pa1, pa2, pa3); SBAR();
    { const int vld = vpv + 2 >= 3 ? vpv - 1 : vpv + 2; DMA(j + 1, 0, vld); } SBAR();
    pv_d0(o, vb0 + vpv * SHM_V, pa0, pa1, pa2, pa3); partialSM(pB0, pB1, m_reg, mnB, alB, fast);
    RESC(alB);
    vpv = vpv == 2 ? 0 : vpv + 1;
    TOPSYNC();
    SBAR(); qkt<MODE>(pA0, pA1, K_lds, R_lds, qr, qp, r32, hi, kc0);
    finishSM(pB0, pB1, alB, l_reg, pa0, pa1, pa2, pa3); SBAR();
    if (j + 2 < NT) { const int vld = vpv + 2 >= 3 ? vpv - 1 : vpv + 2; DMA(j + 2, 1, vld); } SBAR();
    pv_d0(o, vb0 + vpv * SHM_V, pa0, pa1, pa2, pa3); partialSM(pA0, pA1, m_reg, mnA, alA, fast);
    RESC(alA);
    vpv = vpv == 2 ? 0 : vpv + 1;
  }
  TOPSYNC();
  SBAR(); qkt<MODE>(pB0, pB1, K_lds + SHM_K, R_lds + SHM_R, qr, qp, r32, hi, kc0);
  finishSM(pA0, pA1, alA, l_reg, pa0, pa1, pa2, pa3); SBAR();
  pv_d0(o, vb0 + vpv * SHM_V, pa0, pa1, pa2, pa3); partialSM(pB0, pB1, m_reg, mnB, alB, fast);
  RESC(alB);
  vpv = vpv == 2 ? 0 : vpv + 1;
  finishSM(pB0, pB1, alB, l_reg, pa0, pa1, pa2, pa3); SBAR();
  pv_d0(o, vb0 + vpv * SHM_V, pa0, pa1, pa2, pa3);
  }
#undef DMAK1
#undef DMAV1
  __builtin_amdgcn_s_setprio(0);
#undef GL
#undef DMA
#undef TOPSYNC
#undef RESC
  if (hi == 0) li_l[r32] = l_reg;
  asm volatile("s_waitcnt lgkmcnt(0)" ::: "memory");
  float rli[16];
#pragma unroll
  for (int r = 0; r < 16; ++r) rli[r] = __builtin_amdgcn_rcpf(li_l[crow(r, hi)]);
  if constexpr (MODE == 1) {
    const unsigned short* zb = (const unsigned short*)(p.ws + OFF_P1) + 704 + h * 128;
    unsigned short* og = (unsigned short*)(p.ws + OFF_H) + h * 128;
#pragma unroll
    for (int r = 0; r < 16; ++r) { const size_t row = tok0 + crow(r, hi);
#pragma unroll
      for (int d0 = 0; d0 < 4; ++d0) { const int col = d0 * 32 + r32;
        const float v = o[d0][r] * rli[r] * bf2f(zb[row * 1792 + col]);
        og[row * 1024 + col] = (unsigned short)(cvtpk(v, v) & 0xffff); } }
  } else {
    const int c = wid & 1, g = wid >> 1;
    float* X = (float*)lds + g * 32 * 128;
    const float lam = *(const float*)(p.ws + OFF_LAM);
    __syncthreads();
    if (c == 1) {
#pragma unroll
      for (int r = 0; r < 16; ++r) { const float s = rli[r] * lam;
#pragma unroll
        for (int d0 = 0; d0 < 4; ++d0) X[crow(r, hi) * 128 + d0 * 32 + r32] = o[d0][r] * s; }
    }
    __syncthreads();
    if (c == 0) {
      const unsigned short* zb = (const unsigned short*)(p.ws + OFF_P0) + 3072 + h * 128;
      unsigned short* og = (unsigned short*)(p.ws + OFF_OG0) + h * 128;
      float gsub[4];
#pragma unroll
      for (int d0 = 0; d0 < 4; ++d0) gsub[d0] = p.subln_g[d0 * 32 + r32] * 0.8f;
#pragma unroll
      for (int r = 0; r < 16; ++r) { const size_t row = tok0 + crow(r, hi);
        float v[4], ss = 0;
#pragma unroll
        for (int d0 = 0; d0 < 4; ++d0) { v[d0] = o[d0][r] * rli[r] - X[crow(r, hi) * 128 + d0 * 32 + r32]; ss += v[d0] * v[d0]; }
        ss += __shfl_xor(ss, 1); ss += __shfl_xor(ss, 2); ss += __shfl_xor(ss, 4); ss += __shfl_xor(ss, 8); ss += __shfl_xor(ss, 16);
        const float rstd = rsqrtf(ss * (1.f / 128.f) + RMS_EPS);
#pragma unroll
        for (int d0 = 0; d0 < 4; ++d0) { const int col = d0 * 32 + r32;
          const float w = v[d0] * rstd * gsub[d0] * bf2f(zb[row * 4096 + col]);
          og[row * 1024 + col] = (unsigned short)(cvtpk(w, w) & 0xffff); } }
    }
    __syncthreads();
  }
}

template <int MODE>
__device__ __forceinline__ void attn_phase(const Params& p, char* lds) {
  constexpr int NTILE = MODE == 0 ? 1024 : 512;
  const int nslot = gridDim.x >> 3, xcd = blockIdx.x & 7, slot = blockIdx.x >> 3;
  bool fast;
  { const int tid = otid(), lane = tid & 63, wid = tid >> 6;
    const float* bq = (const float*)(p.ws + OFF_BND) + (MODE == 0 ? 0 : 2) * 8192; const float* bk = bq + 8192;
    float mq = 0.f, mk = 0.f;
#pragma unroll
    for (int i = 0; i < 16; ++i) { mq = fmaxf(mq, bq[i * 512 + tid]); mk = fmaxf(mk, bk[i * 512 + tid]); }
    for (int o = 32; o >= 1; o >>= 1) { mq = fmaxf(mq, __shfl_xor(mq, o)); mk = fmaxf(mk, __shfl_xor(mk, o)); }
    float* red = (float*)(lds + 98304);
    __syncthreads();
    if (lane == 0) { red[wid] = mq; red[8 + wid] = mk; }
    __syncthreads();
    mq = red[0]; mk = red[8];
#pragma unroll
    for (int i = 1; i < 8; ++i) { mq = fmaxf(mq, red[i]); mk = fmaxf(mk, red[8 + i]); }
    const float bound = (MODE == 0 ? 1.f : 3.f) * sqrtf(mq * mk) * 1.02f;
    fast = bound < 100.f;
    __syncthreads(); }
  for (int s = slot; s < NTILE / 8; s += nslot) {
    const int tile = (xcd + 8 * (s >> 5)) * 32 + (s & 31);
    if (fast) attn_tile<MODE, true>(p, tile, lds); else attn_tile<MODE, false>(p, tile, lds);
  }
}

#define XB_TMO      128
#define XB_XCNT(j)  (256  + 64 * (j))
#define XB_XSUB(j)  (1280 + 64 * (j))
#define XB_XGEN(j)  (2304 + 64 * (j))
#define XB_TOP      3328
#define XB_TOPGEN   3392
#define XCD_BAR_WORDS 3456
#define XB_SPIN_CAP (1u << 22)
#define LAS __attribute__((address_space(3)))
__device__ __forceinline__ unsigned xb_ld(unsigned* p)              { return __hip_atomic_load(p, __ATOMIC_RELAXED, __HIP_MEMORY_SCOPE_AGENT); }
__device__ __forceinline__ unsigned xb_add(unsigned* p, unsigned v) { return __hip_atomic_fetch_add(p, v, __ATOMIC_RELAXED, __HIP_MEMORY_SCOPE_AGENT); }
__device__ __forceinline__ unsigned xb_xcc_id() { return (unsigned)__builtin_amdgcn_s_getreg((3 << 11) | 20) & 0xFu; }
#define XB_SPIN(cond, bar) do { unsigned _sp = 0; while (cond) { __builtin_amdgcn_s_sleep(1); \
    if ((++_sp & 255u) == 0u) { if (xb_ld(&(bar)[XB_TMO])) break; if (_sp > XB_SPIN_CAP) { atomicAdd(&(bar)[XB_TMO], 1u); break; } } } } while (0)
struct XcdBarrier { unsigned* bar; unsigned x; volatile LAS unsigned* st; };
__device__ __forceinline__ XcdBarrier xcd_barrier_post(unsigned* bar, volatile LAS unsigned* st) {
  XcdBarrier b; b.bar = bar; b.x = xb_xcc_id(); b.st = st;
  if (threadIdx.x == 0) (void)xb_add(&bar[XB_XCNT(b.x)], 1u);
  return b;
}
__device__ __forceinline__ void xcd_barrier_complete(unsigned* bar, unsigned x, unsigned& nloc, unsigned& nx) {
  const unsigned G = gridDim.x * gridDim.y * gridDim.z;
  unsigned sum, cnt, mine, sp = 0u;
  for (;;) {
    sum = 0u; cnt = 0u; mine = 0u;
#pragma unroll
    for (unsigned j = 0; j < 16; ++j) { const unsigned c = xb_ld(&bar[XB_XCNT(j)]); sum += c; cnt += (c > 0u) ? 1u : 0u; mine = (j == x) ? c : mine; }
    if (sum == G) break;
    __builtin_amdgcn_s_sleep(1);
    if ((++sp & 255u) == 0u) { if (xb_ld(&bar[XB_TMO])) break; if (sp > XB_SPIN_CAP) { atomicAdd(&bar[XB_TMO], 1u); break; } }
  }
  nloc = mine > 0u ? mine : 1u; nx = cnt > 0u ? cnt : 1u;
}
__device__ __forceinline__ void xcd_barrier(const XcdBarrier& b) {
  asm volatile("s_waitcnt vmcnt(0)" ::: "memory");
  __syncthreads();
  if (threadIdx.x == 0) {
    unsigned* bar = b.bar;
    __builtin_amdgcn_s_waitcnt(0);
    unsigned nloc = b.st[0], nx = b.st[1];
    if (nloc == 0u) { xcd_barrier_complete(bar, b.x, nloc, nx); b.st[0] = nloc; b.st[1] = nx; }
    const unsigned old = xb_add(&bar[XB_XSUB(b.x)], 1u);
    const unsigned gen = old / nloc;
    if (old + 1u == (gen + 1u) * nloc) {
      __builtin_amdgcn_fence(__ATOMIC_RELEASE, "agent");
      asm volatile("s_waitcnt vmcnt(0)" ::: "memory");
      const unsigned og = xb_add(&bar[XB_TOP], 1u);
      const unsigned tg = og / nx;
      if (og + 1u == (tg + 1u) * nx) xb_add(&bar[XB_TOPGEN], 1u);
      else XB_SPIN(xb_ld(&bar[XB_TOPGEN]) == tg, bar);
      __builtin_amdgcn_fence(__ATOMIC_ACQUIRE, "agent");
      xb_add(&bar[XB_XGEN(b.x)], 1u);
      asm volatile("s_waitcnt vmcnt(0)" ::: "memory");
    } else {
      XB_SPIN(xb_ld(&bar[XB_XGEN(b.x)]) == gen, bar);
      __builtin_amdgcn_fence(__ATOMIC_ACQUIRE, "agent");
      asm volatile("s_waitcnt vmcnt(0)" ::: "memory");
    }
  }
  __syncthreads();
}

template <int PH> __device__ __forceinline__ void run_phase(const Params& p, char* lds) {
  const bf16* H = (const bf16*)(p.ws + OFF_H);
  const float* mod = (const float*)(p.ws + OFF_MOD);
  if constexpr (PH == 0) prep_phase(p, lds);
  if constexpr (PH == 1) norm_phase(p.x, p.norm_g0, mod, (bf16*)(p.ws + OFF_H), nullptr);
  if constexpr (PH == 2) gemm_phase(p, G_PROJ0, H, 0, (const bf16*)(p.ws + OFF_WIN0T), 1024, 16, lds);
  if constexpr (PH == 3) attn_phase<0>(p, lds);
  if constexpr (PH == 4) gemm_phase(p, G_OUT0, (const bf16*)(p.ws + OFF_OG0), 1024, (const bf16*)(p.ws + OFF_WOUT0T), 1024, 4, lds);
  if constexpr (PH == 5) norm_phase(p.out, p.norm_g1, mod + 2 * 3072, (bf16*)(p.ws + OFF_H), nullptr);
  if constexpr (PH == 6) gemm_phase(p, G_PROJ1, H, 0, (const bf16*)(p.ws + OFF_WIN1T), 1024, 7, lds);
  if constexpr (PH == 7) { gemm_phase(p, G_Q, (const bf16*)(p.ws + OFF_P1), 1792, (const bf16*)(p.ws + OFF_WQBT), 384, 6, lds);
                           gemm_phase(p, G_KV, (const bf16*)(p.ws + OFF_P1) + 384, 1792, (const bf16*)(p.ws + OFF_WKVBT), 256, 8, lds); }
  if constexpr (PH == 8) attn_phase<1>(p, lds);
  if constexpr (PH == 9) gemm_phase(p, G_OUT1, H, 1024, (const bf16*)(p.ws + OFF_WOUT1T), 1024, 4, lds);
  if constexpr (PH == 10) norm_phase(p.out, p.fin_g, nullptr, nullptr, p.out);
}
template <int PH> __global__ __launch_bounds__(512, 1) void phase_k(Params p) {
  extern __shared__ __attribute__((aligned(16))) char lds[];
  run_phase<PH>(p, lds);
}
__global__ __launch_bounds__(512, 1) void mega(Params p) {
  extern __shared__ __attribute__((aligned(16))) char lds[];
  cg::grid_group grid = cg::this_grid();
  unsigned* bar = (unsigned*)(p.ws + OFF_BAR);
  if (threadIdx.x == 0) { ((unsigned*)(lds + XB_LDS_OFF))[0] = 0u; ((unsigned*)(lds + XB_LDS_OFF))[1] = 0u; }
  if (blockIdx.x == 0) for (int i = threadIdx.x; i < XCD_BAR_WORDS; i += 512) bar[i] = 0u;
  run_phase<0>(p, lds); grid.sync();
  const XcdBarrier xb = xcd_barrier_post(bar, (volatile LAS unsigned*)(lds + XB_LDS_OFF));
  run_phase<1>(p, lds); xcd_barrier(xb);
  run_phase<2>(p, lds); xcd_barrier(xb);
  run_phase<3>(p, lds); xcd_barrier(xb);
  run_phase<4>(p, lds); xcd_barrier(xb);
  run_phase<6>(p, lds); xcd_barrier(xb);
  run_phase<7>(p, lds); xcd_barrier(xb);
  run_phase<8>(p, lds); xcd_barrier(xb);
  run_phase<9>(p, lds);
}
template <int PH> static void launch_phase(const Params& p, int grid, hipStream_t stream) {
  (void)hipFuncSetAttribute((const void*)phase_k<PH>, hipFuncAttributeMaxDynamicSharedMemorySize, LDS_BYTES);
  hipLaunchKernelGGL(phase_k<PH>, dim3(grid), dim3(512), LDS_BYTES, stream, p);
}

extern "C" void kernel_launch(void* const* d_in, const int* in_sizes, int n_in, void* d_out, int out_size, void* d_ws, size_t ws_size, hipStream_t stream) {
  static int grid_blocks = 0;
  if (!grid_blocks) {
    if (ws_size < WS_NEED) { fprintf(stderr, "kernel_launch: ws too small %zu < %zu\n", ws_size, WS_NEED); return; }
    int dev = 0, cus = 0, per_cu = 0;
    (void)hipGetDevice(&dev);
    (void)hipDeviceGetAttribute(&cus, hipDeviceAttributeMultiprocessorCount, dev);
    (void)hipFuncSetAttribute((const void*)mega, hipFuncAttributeMaxDynamicSharedMemorySize, LDS_BYTES);
    (void)hipOccupancyMaxActiveBlocksPerMultiprocessor(&per_cu, mega, 512, LDS_BYTES);
    if (per_cu < 1) { fprintf(stderr, "kernel_launch: occupancy query returned %d\n", per_cu); return; }
    grid_blocks = (cus / 8) * 8;
  }
  Params p{};
  p.x = (const float*)d_in[0]; p.c = (const float*)d_in[1]; p.pos = (const int*)d_in[2];
  p.ada_w0 = (const float*)d_in[3]; p.ada_b0 = (const float*)d_in[4]; p.norm_g0 = (const float*)d_in[5]; p.w_in0 = (const float*)d_in[6];
  p.lq1 = (const float*)d_in[7]; p.lk1 = (const float*)d_in[8]; p.lq2 = (const float*)d_in[9]; p.lk2 = (const float*)d_in[10];
  p.subln_g = (const float*)d_in[11]; p.w_out0 = (const float*)d_in[12];
  p.ada_w1 = (const float*)d_in[13]; p.ada_b1 = (const float*)d_in[14]; p.norm_g1 = (const float*)d_in[15]; p.w_in1 = (const float*)d_in[16];
  p.qa_g = (const float*)d_in[17]; p.w_qb = (const float*)d_in[18]; p.kva_g = (const float*)d_in[19]; p.w_kvb = (const float*)d_in[20];
  p.w_out1 = (const float*)d_in[21]; p.fin_g = (const float*)d_in[22];
  p.out = (float*)d_out; p.ws = (char*)d_ws;
#if MK_COOP
  void* args[] = {&p};
  hipError_t e = hipLaunchCooperativeKernel((const void*)mega, dim3(grid_blocks), dim3(512), args, LDS_BYTES, stream);
  if (e != hipSuccess) fprintf(stderr, "cooperative launch failed: %s (grid %d)\n", hipGetErrorString(e), grid_blocks);
#else
  launch_phase<0>(p, grid_blocks, stream); launch_phase<1>(p, grid_blocks, stream); launch_phase<2>(p, grid_blocks, stream); launch_phase<3>(p, grid_blocks, stream);
  launch_phase<4>(p, grid_blocks, stream); launch_phase<5>(p, grid_blocks, stream); launch_phase<6>(p, grid_blocks, stream); launch_phase<7>(p, grid_blocks, stream);
  launch_phase<8>(p, grid_blocks, stream); launch_phase<9>(p, grid_blocks, stream); launch_phase<10>(p, grid_blocks, stream);
#endif
}
```

```cpp
#include <hip/hip_runtime.h>
#include <hip/hip_bf16.h>
#include <hip/hip_cooperative_groups.h>
#include <cstdio>
#include <cstdint>
namespace cg = cooperative_groups;

#ifndef MK_REP
#define MK_REP 0
#endif
#ifndef MK_COOP
#define MK_COOP 1
#endif

using bf16 = __hip_bfloat16;
using bf16x8 = __attribute__((ext_vector_type(8))) short;
using s16x4  = __attribute__((ext_vector_type(4))) short;
using f32x16 = __attribute__((ext_vector_type(16))) float;
using f32x4  = __attribute__((ext_vector_type(4))) float;
using u32x4  = __attribute__((ext_vector_type(4))) unsigned;
using u32x2  = __attribute__((ext_vector_type(2))) unsigned;

constexpr int TOK = 16384, SEQ = 8192, DM = 1024;
constexpr float RMS_EPS = 1e-6f;
constexpr float QS0 = 0.1803368777036667f;
constexpr float QS1 = 0.10411754995584488f;
constexpr float THR2 = 11.0f;
constexpr size_t MiB = 1u << 20;
constexpr size_t OFF_MOD = 0;
constexpr size_t OFF_LAM = 65536;
constexpr size_t OFF_BAR = 131072;
constexpr size_t OFF_SSQ = 262144;
constexpr size_t OFF_CNT = 524288;
constexpr size_t OFF_BND = 589824;
constexpr size_t OFF_CS = 1 * MiB;
constexpr size_t OFF_WIN0T = 8 * MiB;
constexpr size_t OFF_WOUT0T = 16 * MiB;
constexpr size_t OFF_WIN1T = 18 * MiB;
constexpr size_t OFF_WQBT = 22 * MiB;
constexpr size_t OFF_WKVBT = 24 * MiB;
constexpr size_t OFF_WOUT1T = 25 * MiB;
constexpr size_t OFF_H = 28 * MiB;
constexpr size_t OFF_OG0 = 60 * MiB;
constexpr size_t OFF_P0 = 92 * MiB;
constexpr size_t OFF_Q1 = 60 * MiB;
constexpr size_t OFF_P1 = 108 * MiB;
constexpr size_t OFF_KV1 = 164 * MiB;
constexpr size_t WS_NEED = 228 * MiB;
constexpr int LDS_BYTES = 146 * 1024 + 256;
constexpr int XB_LDS_OFF = 146 * 1024 + 240;

struct Params {
  const float *x, *c; const int* pos;
  const float *ada_w0, *ada_b0, *norm_g0, *w_in0, *lq1, *lk1, *lq2, *lk2, *subln_g, *w_out0;
  const float *ada_w1, *ada_b1, *norm_g1, *w_in1, *qa_g, *w_qb, *kva_g, *w_kvb, *w_out1, *fin_g;
  float* out; char* ws;
};

__device__ const float INVF[32] = {1.000000000e+00f, 7.498942018e-01f, 5.623413324e-01f, 4.216965139e-01f, 3.162277639e-01f, 2.371373773e-01f, 1.778279394e-01f, 1.333521456e-01f, 1.000000015e-01f, 7.498942316e-02f, 5.623413250e-02f, 4.216964915e-02f, 3.162277490e-02f, 2.371373773e-02f, 1.778279431e-02f, 1.333521400e-02f, 9.999999776e-03f, 7.498942316e-03f, 5.623413250e-03f, 4.216964822e-03f, 3.162277630e-03f, 2.371373819e-03f, 1.778279431e-03f, 1.333521446e-03f, 1.000000047e-03f, 7.498941850e-04f, 5.623413017e-04f, 4.216965172e-04f, 3.162277571e-04f, 2.371373703e-04f, 1.778279402e-04f, 1.333521504e-04f};

#define SBAR() __builtin_amdgcn_sched_barrier(0)
__device__ __forceinline__ int crow(int r, int hi) { return (r & 3) + 8 * (r >> 2) + 4 * hi; }
__device__ __forceinline__ unsigned cvtpk(float lo, float hi) {
  unsigned r; asm("v_cvt_pk_bf16_f32 %0, %1, %2" : "=v"(r) : "v"(lo), "v"(hi)); return r;
}
__device__ __forceinline__ int otid() { int t; asm volatile("v_mov_b32 %0, %1" : "=v"(t) : "v"(threadIdx.x)); return t; }
__device__ __forceinline__ float bf2f(unsigned short u) { return __uint_as_float(((unsigned)u) << 16); }
__device__ __forceinline__ float siluf(float v) { return v * __builtin_amdgcn_rcpf(1.f + __expf(-v)); }

__device__ void tr_job(const float* __restrict__ src, int K, int N, int NP, bf16* __restrict__ dst, int idx, const float* __restrict__ gs, float* T) {
  const int tid = otid(), kt = K >> 6, tk = idx % kt, tn = idx / kt, k0 = tk * 64, n0 = tn * 64;
  { const int row = tid >> 3, c8 = (tid & 7) * 8;
    f32x4 a = {0, 0, 0, 0}, b = {0, 0, 0, 0};
    if (n0 < N) { const float* s = src + (size_t)(k0 + row) * N + n0 + c8; a = *(const f32x4*)s; b = *(const f32x4*)(s + 4); }
    float g = gs ? gs[k0 + row] : 1.f;
    float* t = T + row * 65 + c8;
    t[0] = a[0] * g; t[1] = a[1] * g; t[2] = a[2] * g; t[3] = a[3] * g; t[4] = b[0] * g; t[5] = b[1] * g; t[6] = b[2] * g; t[7] = b[3] * g; }
  __syncthreads();
  { const int n = tid >> 3, kc = (tid & 7) * 8; const float* t = T + kc * 65 + n;
    const int c5 = n & 31, np = (n & 32) | (16 * ((c5 >> 2) & 1) + 4 * (c5 >> 3) + (c5 & 3));
    u32x4 w = {cvtpk(t[0], t[65]), cvtpk(t[130], t[195]), cvtpk(t[260], t[325]), cvtpk(t[390], t[455])};
    *(u32x4*)(dst + ((size_t)tk * NP + n0 + np) * 64 + kc) = w; }
  __syncthreads();
}

__device__ __forceinline__ void prep_phase(const Params& p, char* lds) {
  const int tid = otid();
  float* T = (float*)lds;
  float* mod = (float*)(p.ws + OFF_MOD);
  constexpr int J_MOD = 192, J_T0 = 1024, J_T1 = 256, J_T2 = 448, J_T3 = 144, J_T4 = 128, J_T5 = 256, J_CS = 1024;
  constexpr int J_TOTAL = J_MOD + J_T0 + J_T1 + J_T2 + J_T3 + J_T4 + J_T5 + J_CS;
  for (int i = blockIdx.x * 512 + tid; i < 4 * TOK + 128 + 32768; i += gridDim.x * 512) {
    if (i < 4 * TOK) ((float*)(p.ws + OFF_SSQ))[i] = 0.f; else if (i < 4 * TOK + 128) ((unsigned*)(p.ws + OFF_CNT))[i - 4 * TOK] = 0u;
    else ((float*)(p.ws + OFF_BND))[i - 4 * TOK - 128] = 0.f; }
  if (blockIdx.x == gridDim.x - 1 && tid < 64) {
    float a = p.lq1[tid] * p.lk1[tid], b = p.lq2[tid] * p.lk2[tid];
    for (int o = 32; o >= 1; o >>= 1) { a += __shfl_xor(a, o); b += __shfl_xor(b, o); }
    if (tid == 0) *(float*)(p.ws + OFF_LAM) = expf(a) - expf(b) + 0.2f;
  }
  for (int job = blockIdx.x; job < J_TOTAL; job += gridDim.x) {
    int j = job;
    if (j < J_MOD) {
      const int l = j / 96, cgp = j % 96, nl = tid & 31, n = cgp * 32 + nl, kg = tid >> 5;
      const float* W = l ? p.ada_w1 : p.ada_w0; const float* Bv = l ? p.ada_b1 : p.ada_b0;
      float a0 = 0, a1 = 0;
      for (int k = kg * 64; k < kg * 64 + 64; ++k) {
        float w = W[(size_t)k * 3072 + n];
        a0 += siluf(p.c[k]) * w; a1 += siluf(p.c[1024 + k]) * w; }
      T[(kg * 32 + nl) * 2 + 0] = a0; T[(kg * 32 + nl) * 2 + 1] = a1;
      __syncthreads();
      if (tid < 64) { const int b = tid >> 5; float s = 0;
        for (int g = 0; g < 16; ++g) s += T[(g * 32 + nl) * 2 + b];
        mod[(l * 2 + b) * 3072 + n] = s + Bv[n]; }
      __syncthreads();
      continue;
    }
    j -= J_MOD;
    if (j < J_T0) { tr_job(p.w_in0, 1024, 4096, 4096, (bf16*)(p.ws + OFF_WIN0T), j, nullptr, T); continue; } j -= J_T0;
    if (j < J_T1) { tr_job(p.w_out0, 1024, 1024, 1024, (bf16*)(p.ws + OFF_WOUT0T), j, nullptr, T); continue; } j -= J_T1;
    if (j < J_T2) { tr_job(p.w_in1, 1024, 1728, 1792, (bf16*)(p.ws + OFF_WIN1T), j, nullptr, T); continue; } j -= J_T2;
    if (j < J_T3) { tr_job(p.w_qb, 384, 1536, 1536, (bf16*)(p.ws + OFF_WQBT), j, p.qa_g, T); continue; } j -= J_T3;
    if (j < J_T4) { tr_job(p.w_kvb, 256, 2048, 2048, (bf16*)(p.ws + OFF_WKVBT), j, p.kva_g, T); continue; } j -= J_T4;
    if (j < J_T5) { tr_job(p.w_out1, 1024, 1024, 1024, (bf16*)(p.ws + OFF_WOUT1T), j, nullptr, T); continue; } j -= J_T5;
    { const int idx = j * 512 + tid, tok = idx >> 5, i = idx & 31;
      const float ang = (float)p.pos[tok] * INVF[i];
      const double rev = (double)ang * 0.15915494309189535;
      const float fr = (float)(rev - rint(rev));
      float2 cs; cs.x = __builtin_amdgcn_cosf(fr); cs.y = __builtin_amdgcn_sinf(fr);
      ((float2*)(p.ws + OFF_CS))[idx] = cs; }
  }
}

__device__ __forceinline__ void norm_phase(const float* xin, const float* __restrict__ g, const float* __restrict__ mod, bf16* __restrict__ hout, float* fout) {
  const int tid = otid(), lane = tid & 63, wid = tid >> 6;
  for (int row = blockIdx.x * 8 + wid; row < TOK; row += gridDim.x * 8) {
    const float* xr = xin + (size_t)row * DM;
    f32x4 v[4]; float ss = 0;
#pragma unroll
    for (int i = 0; i < 4; ++i) { v[i] = *(const f32x4*)(xr + (i * 64 + lane) * 4); ss += v[i][0] * v[i][0] + v[i][1] * v[i][1] + v[i][2] * v[i][2] + v[i][3] * v[i][3]; }
    for (int o = 32; o >= 1; o >>= 1) ss += __shfl_xor(ss, o);
    const float rstd = rsqrtf(ss * (1.f / DM) + RMS_EPS);
    if (mod) {
      const float* sh = mod + (row >> 13) * 3072; const float* sc = sh + 1024;
#pragma unroll
      for (int i = 0; i < 4; ++i) { const int col = (i * 64 + lane) * 4;
        f32x4 gg = *(const f32x4*)(g + col), s1 = *(const f32x4*)(sc + col), s0 = *(const f32x4*)(sh + col);
        float o0 = v[i][0] * rstd * gg[0] * (1.f + s1[0]) + s0[0], o1 = v[i][1] * rstd * gg[1] * (1.f + s1[1]) + s0[1];
        float o2 = v[i][2] * rstd * gg[2] * (1.f + s1[2]) + s0[2], o3 = v[i][3] * rstd * gg[3] * (1.f + s1[3]) + s0[3];
        u32x2 w = {cvtpk(o0, o1), cvtpk(o2, o3)};
        *(u32x2*)(hout + ((size_t)(i * 4 + (lane >> 4)) * TOK + row) * 64 + (lane & 15) * 4) = w; }
    } else {
#pragma unroll
      for (int i = 0; i < 4; ++i) { const int col = (i * 64 + lane) * 4;
        f32x4 gg = *(const f32x4*)(g + col);
        f32x4 o = {v[i][0] * rstd * gg[0], v[i][1] * rstd * gg[1], v[i][2] * rstd * gg[2], v[i][3] * rstd * gg[3]};
        *(f32x4*)(fout + (size_t)row * DM + col) = o; }
    }
  }
}

enum { G_PROJ0 = 0, G_OUT0 = 1, G_PROJ1 = 2, G_Q = 3, G_KV = 4, G_OUT1 = 5 };
enum { E_PLAIN = 0, E_ROPE = 1, E_SILU = 2, E_SKIP = 3 };
#define GSWZ(row, ch) ((row) * 128 + ((((ch) ^ ((row) >> 1)) & 7) << 4))

#define RAW_BARRIER() do { asm volatile("s_waitcnt lgkmcnt(0)" ::: "memory"); __builtin_amdgcn_s_barrier(); } while (0)
__device__ __forceinline__ void gemm_tile(const Params& p, int kind, const bf16* __restrict__ A, int lda, const bf16* __restrict__ Bt, int K, int ntn, int tm, int tn, char* lds) {
  const int tid = otid(), wid = __builtin_amdgcn_readfirstlane(tid >> 6), lane = tid & 63, r32 = lane & 31, hi = lane >> 5, wr = wid >> 1, wc = wid & 1;
  char* As = lds; char* Bs = lds + 65536; float* rs = (float*)(lds + 131072);
  const bool aslab = lda == 0;
  const size_t a_rs = aslab ? 64 : lda, a_ks = aslab ? (size_t)TOK * 64 : 64, b_ks = (size_t)ntn * 256 * 64;
  const bf16* Ag = A + (size_t)(tm * 256) * a_rs; const bf16* Bg = Bt + (size_t)(tn * 256) * 64;
  __syncthreads();
  if (kind == G_Q || kind == G_KV) {
    if (tid < 256) rs[tid] = rsqrtf(((const float*)(p.ws + OFF_SSQ))[(kind == G_Q ? 2 : 3) * TOK + tm * 256 + tid] / (float)K + RMS_EPS);
  }
  f32x16 acc[2][4] = {};
  const int lch = (lane & 7) ^ ((wid * 4 + (lane >> 4)) & 7);
  const bf16* Ap = Ag + (size_t)(wid * 8 + (lane >> 3)) * a_rs + lch * 8; const bf16* Bp = Bg + (size_t)(wid * 8 + (lane >> 3)) * 64 + lch * 8;
#define GLDS(st, kt) do { _Pragma("unroll") for (int i = 0; i < 4; ++i) \
      __builtin_amdgcn_global_load_lds((const unsigned*)(Ap + (size_t)(i * 64) * a_rs + (kt) * a_ks), (unsigned*)(As + (st) * 32768 + (i * 8 + wid) * 1024), 16, 0, 0); \
    _Pragma("unroll") for (int i = 0; i < 4; ++i) \
      __builtin_amdgcn_global_load_lds((const unsigned*)(Bp + (size_t)(i * 64) * 64 + (kt) * b_ks), (unsigned*)(Bs + (st) * 32768 + (i * 8 + wid) * 1024), 16, 0, 0); } while (0)
  const int nk = K >> 6;
  const int ar0 = wr * 64 + r32, br0 = wc * 128 + r32;
  bf16x8 fa[2], fb[4];
#define LDFR(ks) do { const int ch = (ks) * 2 + hi; \
    _Pragma("unroll") for (int mi = 0; mi < 2; ++mi) fa[mi] = *(const bf16x8*)(Ab + GSWZ(ar0 + mi * 32, ch)); \
    _Pragma("unroll") for (int nj = 0; nj < 4; ++nj) fb[nj] = *(const bf16x8*)(Bb + GSWZ(br0 + nj * 32, ch)); } while (0)
#define GPIECE(st, kt, i) do { if ((i) < 4) __builtin_amdgcn_global_load_lds((const unsigned*)(Ap + (size_t)((i) * 64) * a_rs + (kt) * a_ks), (unsigned*)(As + (st) * 32768 + ((i) * 8 + wid) * 1024), 16, 0, 0); \
    else __builtin_amdgcn_global_load_lds((const unsigned*)(Bp + (size_t)(((i) - 4) * 64) * 64 + (kt) * b_ks), (unsigned*)(Bs + (st) * 32768 + (((i) - 4) * 8 + wid) * 1024), 16, 0, 0); } while (0)
#define BAR() do { asm volatile("" ::: "memory"); __builtin_amdgcn_s_barrier(); asm volatile("" ::: "memory"); } while (0)
  GLDS(0, 0);
  asm volatile("s_waitcnt vmcnt(0)" ::: "memory"); BAR();
  if (wid >= 4) BAR();
  for (int kt = 0; kt < nk; ++kt) {
    const bool more = kt + 1 < nk; const int st1 = (kt + 1) & 1;
    const char* Ab = As + (kt & 1) * 32768; const char* Bb = Bs + (kt & 1) * 32768;
#pragma unroll
    for (int ks = 0; ks < 4; ++ks) {
      LDFR(ks);
      if (more) { if (ks == 0) { GPIECE(st1, kt + 1, 0); GPIECE(st1, kt + 1, 1); GPIECE(st1, kt + 1, 4); GPIECE(st1, kt + 1, 5); }
                  if (ks == 1) { GPIECE(st1, kt + 1, 2); GPIECE(st1, kt + 1, 3); GPIECE(st1, kt + 1, 6); GPIECE(st1, kt + 1, 7); } }
      if (ks == 3) asm volatile("s_waitcnt vmcnt(0)" ::: "memory");
      SBAR(); BAR();
      asm volatile("s_waitcnt lgkmcnt(0)" ::: "memory"); SBAR();
      __builtin_amdgcn_s_setprio(3);
#pragma unroll
      for (int mi = 0; mi < 2; ++mi)
#pragma unroll
        for (int nj = 0; nj < 4; ++nj) acc[mi][nj] = __builtin_amdgcn_mfma_f32_32x32x16_bf16(fb[nj], fa[mi], acc[mi][nj], 0, 0, 0);
      __builtin_amdgcn_s_setprio(0);
      SBAR(); BAR();
    }
  }
  if (wid < 4) BAR();
#undef BAR
#undef GLDS
#undef LDFR
#undef GPIECE
  int opq; asm volatile("v_mov_b32 %0, 0" : "=v"(opq));
  const int rowb = tm * 256 + wr * 64;
  const float* cst = (const float*)(p.ws + OFF_CS);
#define RG(e, t) ((e) < 4 ? 4 * (t) + (e) : 8 + 4 * (t) + (e) - 4)
#pragma unroll
  for (int q = 0; q < 2; ++q) {
    const int n64 = tn * 4 + wc * 2 + q;
    if (kind == G_OUT0 || kind == G_OUT1) {
      continue;
    }
    int mode = E_PLAIN, ldc; float mul = 1.f; bf16* dst;
    if (kind == G_PROJ0) { const int sec = n64 >> 4; mode = sec < 2 ? E_ROPE : (sec == 3 ? E_SILU : E_PLAIN); mul = sec == 0 ? QS0 : 1.f; dst = (bf16*)(p.ws + OFF_P0); ldc = 4096; }
    else if (kind == G_PROJ1) { mode = n64 < 10 ? E_PLAIN : (n64 == 10 ? E_ROPE : (n64 < 27 ? E_SILU : E_SKIP)); dst = (bf16*)(p.ws + OFF_P1); ldc = 1792; }
    else if (kind == G_Q) { mode = (n64 % 3 == 2) ? E_ROPE : E_PLAIN; mul = QS1; dst = (bf16*)(p.ws + OFF_Q1); ldc = 1536; }
    else { dst = (bf16*)(p.ws + OFF_KV1); ldc = 2048; }
    if (mode == E_SKIP) continue;
    const bool use_rs = (kind == G_Q || kind == G_KV);
    int bcat = -1, bsl = 0;
    if (kind == G_PROJ0) { if (n64 < 32) { bcat = n64 >> 4; bsl = n64 & 15; } }
    else if (kind == G_PROJ1) { if (n64 == 10) { bcat = 3; bsl = 31; } }
    else if (kind == G_Q) { bcat = 2; bsl = n64; }
    else if (kind == G_KV) { if ((n64 & 3) < 2) { bcat = 3; bsl = n64; } }
    const bool want_ss = (kind == G_PROJ1 && n64 < 10) || bcat >= 0;
    float ssacc[2] = {0.f, 0.f};
#pragma unroll
    for (int mi = 0; mi < 2; ++mi) {
      const int rl = wr * 64 + mi * 32 + r32, row = tm * 256 + rl;
      const float sm = (use_rs ? rs[rl] : 1.f) * mul;
      bf16* drow = dst + (size_t)row * ldc + n64 * 64 + hi * 8;
#pragma unroll
      for (int t = 0; t < 2; ++t) {
        float v0[8], v1[8];
#pragma unroll
        for (int e = 0; e < 8; ++e) { v0[e] = acc[mi][2 * q][RG(e, t)] * sm; v1[e] = acc[mi][2 * q + 1][RG(e, t)] * sm; }
        if (mode == E_ROPE) {
          const float* cp = cst + ((size_t)row * 32 + t * 16 + hi * 8) * 2;
#pragma unroll
          for (int e2 = 0; e2 < 4; ++e2) { const f32x4 c4 = *(const f32x4*)(cp + e2 * 4);
            { const int e = 2 * e2; const float o0 = v0[e] * c4[0] - v1[e] * c4[1], o1 = v1[e] * c4[0] + v0[e] * c4[1]; v0[e] = o0; v1[e] = o1; }
            { const int e = 2 * e2 + 1; const float o0 = v0[e] * c4[2] - v1[e] * c4[3], o1 = v1[e] * c4[2] + v0[e] * c4[3]; v0[e] = o0; v1[e] = o1; } }
        } else if (mode == E_SILU) {
#pragma unroll
          for (int e = 0; e < 8; ++e) { v0[e] = siluf(v0[e]); v1[e] = siluf(v1[e]); }
        }
        if (want_ss) {
#pragma unroll
          for (int e = 0; e < 8; ++e) ssacc[mi] += v0[e] * v0[e] + v1[e] * v1[e]; }
        u32x4 w0 = {cvtpk(v0[0], v0[1]), cvtpk(v0[2], v0[3]), cvtpk(v0[4], v0[5]), cvtpk(v0[6], v0[7])};
        u32x4 w1 = {cvtpk(v1[0], v1[1]), cvtpk(v1[2], v1[3]), cvtpk(v1[4], v1[5]), cvtpk(v1[6], v1[7])};
        *(u32x4*)(drow + t * 16) = w0; *(u32x4*)(drow + 32 + t * 16) = w1;
      }
    }
    if (bcat >= 0) {
      float m = fmaxf(ssacc[0] + __shfl_xor(ssacc[0], 32), ssacc[1] + __shfl_xor(ssacc[1], 32));
      m = fmaxf(m, __shfl_xor(m, 1)); m = fmaxf(m, __shfl_xor(m, 2)); m = fmaxf(m, __shfl_xor(m, 4)); m = fmaxf(m, __shfl_xor(m, 8)); m = fmaxf(m, __shfl_xor(m, 16));
      if (lane == 0) ((float*)(p.ws + OFF_BND))[(bcat * 256 + (rowb >> 6)) * 32 + bsl] = m;
    }
    if (kind == G_PROJ1 && n64 < 10) {
      float* sq = (float*)(p.ws + OFF_SSQ) + (n64 < 6 ? 2 : 3) * TOK + rowb;
#pragma unroll
      for (int mi = 0; mi < 2; ++mi) { float ss = ssacc[mi]; ss += __shfl_xor(ss, 32);
        if (hi == 0) __hip_atomic_fetch_add(sq + mi * 32 + r32, ss, __ATOMIC_RELAXED, __HIP_MEMORY_SCOPE_AGENT); }
    }
  }
  if (kind == G_OUT0 || kind == G_OUT1) {
    const float* xo = kind == G_OUT0 ? p.x : p.out;
    const int colb = tn * 256 + wc * 128 + hi * 8;
    const float* gate = (const float*)(p.ws + OFF_MOD) + (kind == G_OUT0 ? 0 : 2) * 3072 + (rowb >> 13) * 3072 + 2048 + colb;
#pragma unroll
    for (int mi = 0; mi < 2; ++mi) {
      const size_t ro = (size_t)(rowb + mi * 32 + r32) * DM + colb;
      const float* xr = xo + ro; float* orow = p.out + ro;
#pragma unroll
      for (int nj = 0; nj < 4; ++nj) {
#pragma unroll
        for (int t = 0; t < 2; ++t) { const int co = nj * 32 + t * 16;
          const f32x4 ga = *(const f32x4*)(gate + co), gb = *(const f32x4*)(gate + co + 4);
          const f32x4 xa = *(const f32x4*)(xr + co), xb = *(const f32x4*)(xr + co + 4);
          f32x4 ra, rb;
#pragma unroll
          for (int e = 0; e < 4; ++e) { ra[e] = xa[e] + ga[e] * acc[mi][nj][RG(e, t)]; rb[e] = xb[e] + gb[e] * acc[mi][nj][RG(e + 4, t)];
            acc[mi][nj][RG(e, t)] = ra[e]; acc[mi][nj][RG(e + 4, t)] = rb[e]; }
          if (kind == G_OUT0 || opq != 0) { *(f32x4*)(orow + co) = ra; *(f32x4*)(orow + co + 4) = rb; } }
        SBAR(); }
    }
    float* ssq = (float*)(p.ws + OFF_SSQ) + (kind == G_OUT0 ? 0 : 1) * TOK;
    unsigned* cnt = (unsigned*)(p.ws + OFF_CNT) + (kind == G_OUT0 ? 0 : 64) + tm;
#pragma unroll
    for (int mi = 0; mi < 2; ++mi) { float ss = 0;
#pragma unroll
      for (int nj = 0; nj < 4; ++nj)
#pragma unroll
        for (int r = 0; r < 16; ++r) ss += acc[mi][nj][r] * acc[mi][nj][r];
      ss += __shfl_xor(ss, 32);
      if (hi == 0) __hip_atomic_fetch_add(ssq + rowb + mi * 32 + r32, ss, __ATOMIC_RELAXED, __HIP_MEMORY_SCOPE_AGENT); }
    asm volatile("s_waitcnt vmcnt(0)" ::: "memory");
    __syncthreads();
    if (tid == 0) { __hip_atomic_fetch_add(cnt, 1u, __ATOMIC_RELAXED, __HIP_MEMORY_SCOPE_AGENT);
      while (__hip_atomic_load(cnt, __ATOMIC_RELAXED, __HIP_MEMORY_SCOPE_AGENT) < 4u) __builtin_amdgcn_s_sleep(1); }
    __syncthreads();
    const float* gvec = (kind == G_OUT0 ? p.norm_g1 : p.fin_g) + colb;
    const float* modl = (const float*)(p.ws + OFF_MOD) + 2 * 3072 + (rowb >> 13) * 3072 + colb;
#pragma unroll
    for (int mi = 0; mi < 2; ++mi) {
      const int row = rowb + mi * 32 + r32;
      const float rstd = rsqrtf(__hip_atomic_load(ssq + row, __ATOMIC_RELAXED, __HIP_MEMORY_SCOPE_AGENT) * (1.f / DM) + RMS_EPS);
      float* orow = p.out + (size_t)row * DM + colb;
#pragma unroll
      for (int nj = 0; nj < 4; ++nj) {
        bf16* hrow = (bf16*)(p.ws + OFF_H) + ((size_t)(tn * 4 + wc * 2 + (nj >> 1)) * TOK + row) * 64 + hi * 8 + (nj & 1) * 32;
#pragma unroll
        for (int t = 0; t < 2; ++t) { const int co = nj * 32 + t * 16;
          const f32x4 ga = *(const f32x4*)(gvec + co), gb = *(const f32x4*)(gvec + co + 4);
          float v[8];
#pragma unroll
          for (int e = 0; e < 4; ++e) { v[e] = acc[mi][nj][RG(e, t)] * rstd * ga[e]; v[e + 4] = acc[mi][nj][RG(e + 4, t)] * rstd * gb[e]; }
          if (kind == G_OUT0) {
            const f32x4 sa = *(const f32x4*)(modl + 1024 + co), sb = *(const f32x4*)(modl + 1024 + co + 4), ha = *(const f32x4*)(modl + co), hb = *(const f32x4*)(modl + co + 4);
#pragma unroll
            for (int e = 0; e < 4; ++e) { v[e] = v[e] * (1.f + sa[e]) + ha[e]; v[e + 4] = v[e + 4] * (1.f + sb[e]) + hb[e]; }
            u32x4 w = {cvtpk(v[0], v[1]), cvtpk(v[2], v[3]), cvtpk(v[4], v[5]), cvtpk(v[6], v[7])};
            *(u32x4*)(hrow + t * 16) = w;
          } else {
            f32x4 oa = {v[0], v[1], v[2], v[3]}, ob = {v[4], v[5], v[6], v[7]};
            *(f32x4*)(orow + co) = oa; *(f32x4*)(orow + co + 4) = ob;
          } }
        SBAR(); }
    }
  }
#undef RG
}

__device__ __forceinline__ void gemm_phase(const Params& p, int kind, const bf16* A, int lda, const bf16* Bt, int K, int ntn, char* lds) {
  const int x = blockIdx.x & 7, slot = blockIdx.x >> 3, nslot = gridDim.x >> 3;
  if (kind == G_KV && nslot == 32) {
    if (slot < 16) { const int w = 48 + slot; gemm_tile(p, kind, A, lda, Bt, K, ntn, x * 8 + (w & 7), w >> 3, lds); }
    else for (int i = 0; i < 3; ++i) { const int w = (slot - 16) * 3 + i; gemm_tile(p, kind, A, lda, Bt, K, ntn, x * 8 + (w & 7), w >> 3, lds); }
    return; }
  for (int w = slot; w < 8 * ntn; w += nslot) gemm_tile(p, kind, A, lda, Bt, K, ntn, x * 8 + (w & 7), w >> 3, lds);
}

#define KSWZ(row, colB) ((row) * 256 + ((colB) ^ (((row) & 7) << 4)))
__device__ __forceinline__ void partialSM(f32x16& p0, f32x16& p1, float& m_reg, float& mn, float& alpha, bool fast) {
  if (fast) {
    alpha = 1.f; mn = 0.f;
#pragma unroll
    for (int r = 0; r < 16; ++r) p0[r] = __builtin_amdgcn_exp2f(p0[r]);
    return;
  }
  float pmax = p0[0];
#pragma unroll
  for (int r = 1; r < 16; ++r) pmax = fmaxf(pmax, p0[r]);
#pragma unroll
  for (int r = 0; r < 16; ++r) pmax = fmaxf(pmax, p1[r]);
  { auto rr = __builtin_amdgcn_permlane32_swap(__float_as_uint(pmax), __float_as_uint(pmax), false, false);
    pmax = fmaxf(__uint_as_float(rr[0]), __uint_as_float(rr[1])); }
  if (__builtin_expect(__all(pmax - m_reg <= THR2), 1)) { mn = m_reg; alpha = 1.f; }
  else { mn = fmaxf(m_reg, pmax); alpha = __builtin_amdgcn_exp2f(m_reg - mn); m_reg = mn; }
#pragma unroll
  for (int r = 0; r < 16; ++r) p0[r] -= mn;
#pragma unroll
  for (int r = 0; r < 16; ++r) p1[r] -= mn;
#pragma unroll
  for (int r = 0; r < 16; ++r) p0[r] = __builtin_amdgcn_exp2f(p0[r]);
}
__device__ __forceinline__ void finishSM(f32x16& p0, f32x16& p1, float alpha, float& l_reg, bf16x8& pa0, bf16x8& pa1, bf16x8& pa2, bf16x8& pa3) {
#pragma unroll
  for (int r = 0; r < 16; ++r) p1[r] = __builtin_amdgcn_exp2f(p1[r]);
  float ps = 0;
#pragma unroll
  for (int r = 0; r < 16; ++r) ps += p0[r];
#pragma unroll
  for (int r = 0; r < 16; ++r) ps += p1[r];
  { auto rr = __builtin_amdgcn_permlane32_swap(__float_as_uint(ps), __float_as_uint(ps), false, false);
    ps = __uint_as_float(rr[0]) + __uint_as_float(rr[1]); }
  l_reg = l_reg * alpha + ps;
#define PK4(P, BASE, OUT) do { unsigned a0 = cvtpk(P[BASE + 0], P[BASE + 1]), a1 = cvtpk(P[BASE + 2], P[BASE + 3]);   \
    unsigned b0 = cvtpk(P[BASE + 4], P[BASE + 5]), b1 = cvtpk(P[BASE + 6], P[BASE + 7]);                              \
    auto r0 = __builtin_amdgcn_permlane32_swap(a0, b0, false, false); auto r1 = __builtin_amdgcn_permlane32_swap(a1, b1, false, false); \
    u32x4 w = {r0[0], r1[0], r0[1], r1[1]}; OUT = *reinterpret_cast<bf16x8*>(&w); } while (0)
  PK4(p0, 0, pa0); PK4(p0, 8, pa1); PK4(p1, 0, pa2); PK4(p1, 8, pa3);
#undef PK4
}
template <int MODE, int NREG>
__device__ __forceinline__ void qkt(f32x16& p0, f32x16& p1, const char* Ks, const char* Rs, const bf16x8* qr, const char* qp, int r32, int hi, int kc0) {
  p0 = f32x16{}; p1 = f32x16{};
  constexpr int NN = MODE == 0 ? 4 : 8;
#pragma unroll
  for (int d0 = 0; d0 < NN; ++d0) { const int cb = kc0 + (d0 * 16 + hi * 8) * 2;
    bf16x8 b0 = *reinterpret_cast<const bf16x8*>(Ks + KSWZ(r32, cb));
    bf16x8 b1 = *reinterpret_cast<const bf16x8*>(Ks + KSWZ(32 + r32, cb));
    p0 = __builtin_amdgcn_mfma_f32_32x32x16_bf16(b0, qr[d0], p0, 0, 0, 0);
    p1 = __builtin_amdgcn_mfma_f32_32x32x16_bf16(b1, qr[d0], p1, 0, 0, 0); }
  if constexpr (MODE == 1) {
#pragma unroll
    for (int d0 = 0; d0 < 4; ++d0) { const int ch = d0 * 2 + hi;
      bf16x8 q; if (8 + d0 < NREG) q = qr[(8 + d0 < NREG) ? 8 + d0 : 0]; else q = *reinterpret_cast<const bf16x8*>(qp + (d0 - (NREG - 8)) * 8192);
      bf16x8 b0 = *reinterpret_cast<const bf16x8*>(Rs + GSWZ(r32, ch));
      bf16x8 b1 = *reinterpret_cast<const bf16x8*>(Rs + GSWZ(32 + r32, ch));
      p0 = __builtin_amdgcn_mfma_f32_32x32x16_bf16(b0, q, p0, 0, 0, 0);
      p1 = __builtin_amdgcn_mfma_f32_32x32x16_bf16(b1, q, p1, 0, 0, 0); }
  }
}
__device__ __forceinline__ int v_st(int k, int c) { const int kk = (k & ~0xC) | ((k & 4) << 1) | ((k & 8) >> 1); return ((kk >> 3) * 4 + (c >> 5)) * 512 + ((kk & 7) * 32 + (c & 31)) * 2; }
__device__ __forceinline__ int v_rd_base(int lane) { return ((lane & 3) << 3) | (((lane >> 2) & 3) << 6) | (((lane >> 4) & 1) << 5) | (((lane >> 5) & 1) << 8); }
constexpr int v_rd_off(int d0, int ks, int half) { return d0 * 512 + ks * 4096 + half * 2048; }
template <int OFF> __device__ __forceinline__ s16x4 tr_read(int vb) {
  s16x4 r; asm volatile("ds_read_b64_tr_b16 %0, %1 offset:%2" : "=&v"(r) : "v"(vb), "i"(OFF)); return r;
}
template <int D0> __device__ __forceinline__ void pv_one(f32x16& od, int vb, bf16x8 pa0, bf16x8 pa1, bf16x8 pa2, bf16x8 pa3) {
  s16x4 l0 = tr_read<v_rd_off(D0, 0, 0)>(vb), h0 = tr_read<v_rd_off(D0, 0, 1)>(vb), l1 = tr_read<v_rd_off(D0, 1, 0)>(vb), h1 = tr_read<v_rd_off(D0, 1, 1)>(vb);
  s16x4 l2 = tr_read<v_rd_off(D0, 2, 0)>(vb), h2 = tr_read<v_rd_off(D0, 2, 1)>(vb), l3 = tr_read<v_rd_off(D0, 3, 0)>(vb), h3 = tr_read<v_rd_off(D0, 3, 1)>(vb);
  asm volatile("s_waitcnt lgkmcnt(0)" : "+v"(l0), "+v"(h0), "+v"(l1), "+v"(h1), "+v"(l2), "+v"(h2), "+v"(l3), "+v"(h3) :: "memory");
#define PK(L, H) (bf16x8){L[0], L[1], L[2], L[3], H[0], H[1], H[2], H[3]}
  od = __builtin_amdgcn_mfma_f32_32x32x16_bf16(pa0, PK(l0, h0), od, 0, 0, 0);
  od = __builtin_amdgcn_mfma_f32_32x32x16_bf16(pa1, PK(l1, h1), od, 0, 0, 0);
  od = __builtin_amdgcn_mfma_f32_32x32x16_bf16(pa2, PK(l2, h2), od, 0, 0, 0);
  od = __builtin_amdgcn_mfma_f32_32x32x16_bf16(pa3, PK(l3, h3), od, 0, 0, 0);
#undef PK
}
__device__ __forceinline__ void pv_d0(f32x16* o, int vb, bf16x8 pa0, bf16x8 pa1, bf16x8 pa2, bf16x8 pa3) {
  pv_one<0>(o[0], vb, pa0, pa1, pa2, pa3); pv_one<1>(o[1], vb, pa0, pa1, pa2, pa3); pv_one<2>(o[2], vb, pa0, pa1, pa2, pa3); pv_one<3>(o[3], vb, pa0, pa1, pa2, pa3);
}

template <int MODE, bool FAST>
__device__ __forceinline__ void attn_tile(const Params& p, int tile, char* lds) {
  constexpr bool fast = FAST;
  constexpr int SHM_V = 16384, SHM_K = 16384, SHM_R = 8192, KVBLK = 64;
  const int tid = otid(), wid = __builtin_amdgcn_readfirstlane(tid >> 6), lane = tid & 63, r32 = lane & 31, hi = lane >> 5;
  char* V_lds = lds; char* K_lds = lds + (MODE == 0 ? 5 : 3) * SHM_V; char* R_lds = K_lds + 2 * SHM_K;
  float* wsf = (float*)(lds + (MODE == 0 ? 147456 : 98304)) + wid * 64; float* li_l = wsf; float* al_l = wsf + 32;
  const bf16 *Qw, *Kh, *Vh, *Rh = nullptr; int tok0, h, kc0 = 0;
  constexpr int LDK = MODE == 0 ? 4096 : 2048, LDR = 1792;
  if constexpr (MODE == 0) {
    const int qb = tile & 63; h = (tile >> 6) & 7; const int b = tile >> 9, c = wid & 1, g = wid >> 1;
    tok0 = b * SEQ + qb * 128 + g * 32; kc0 = c * 128;
    const bf16* P0 = (const bf16*)(p.ws + OFF_P0);
    Qw = P0 + (size_t)(tok0 + r32) * 4096 + h * 128 + c * 64 + hi * 8;
    Kh = P0 + (size_t)(b * SEQ) * 4096 + 1024 + h * 128; Vh = Kh + 1024;
  } else {
    const int qb = tile & 31; h = (tile >> 5) & 7; const int b = tile >> 8;
    tok0 = b * SEQ + qb * 256 + wid * 32;
    Qw = (const bf16*)(p.ws + OFF_Q1) + (size_t)(tok0 + r32) * 1536 + h * 192 + hi * 8;
    Kh = (const bf16*)(p.ws + OFF_KV1) + (size_t)(b * SEQ) * 2048 + h * 256; Vh = Kh + 128;
    Rh = (const bf16*)(p.ws + OFF_P1) + (size_t)(b * SEQ) * 1792 + 640;
  }
  __syncthreads();
  const int krow = 4 * wid + (lane >> 4), klc = (lane & 15) ^ (krow & 7);
  const bf16* kp = Kh + (size_t)krow * LDK + klc * 8;
  const int vkk = (wid >> 1) * 8 + ((lane & 31) >> 2), vk = (vkk & ~0xC) | ((vkk & 4) << 1) | ((vkk & 8) >> 1);
  const bf16* vp = Vh + (size_t)vk * LDK + (2 * (wid & 1) + (lane >> 5)) * 32 + (lane & 3) * 8;
  const int rrow = 8 * wid + (lane >> 3);
  const bf16* rp = MODE == 1 ? Rh + (size_t)rrow * LDR + (((lane & 7) ^ ((rrow >> 1) & 7)) * 8) : nullptr;
#define GL(src, dst) __builtin_amdgcn_global_load_lds((const unsigned*)(src), (unsigned*)(dst), 16, 0, 0)
#define DMA(j, kb, vbi) do { const size_t ko = (size_t)(j) * KVBLK * LDK; \
    GL(kp + ko, K_lds + (kb) * SHM_K + wid * 1024); GL(kp + ko + 32 * LDK, K_lds + (kb) * SHM_K + (wid + 8) * 1024); \
    GL(vp + ko, V_lds + (vbi) * SHM_V + wid * 1024); GL(vp + ko + 32 * LDK, V_lds + (vbi) * SHM_V + (wid + 8) * 1024); \
    if constexpr (MODE == 1) GL(rp + (size_t)(j) * KVBLK * LDR, R_lds + (kb) * SHM_R + wid * 1024); } while (0)
#define TOPSYNC() do { asm volatile("s_waitcnt vmcnt(0)" ::: "memory"); RAW_BARRIER(); } while (0)
#define DMAK1(t, sl) do { const size_t ko = (size_t)(t) * KVBLK * LDK; GL(kp + ko, K_lds + (sl) * SHM_K + wid * 1024); GL(kp + ko + 32 * LDK, K_lds + (sl) * SHM_K + (wid + 8) * 1024); } while (0)
#define DMAV1(t, sl) do { const size_t ko = (size_t)(t) * KVBLK * LDK; GL(vp + ko, V_lds + (sl) * SHM_V + wid * 1024); GL(vp + ko + 32 * LDK, V_lds + (sl) * SHM_V + (wid + 8) * 1024); } while (0)
  if constexpr (MODE == 0) { DMAK1(0, 0); DMAV1(0, 0); DMAK1(1, 1); DMAV1(1, 1); DMAK1(2, 2); DMAV1(2, 2); DMAK1(3, 3); DMAV1(3, 3); }
  else { DMA(0, 0, 0); DMA(1, 1, 1); }
  constexpr int NQR = MODE == 0 ? 4 : (FAST ? 12 : 8);
  float m_reg = -1e30f, l_reg = 0; f32x16 o[4] = {}; bf16x8 qr[NQR];
#pragma unroll
  for (int d0 = 0; d0 < NQR; ++d0) qr[d0] = *(const bf16x8*)(Qw + d0 * 16);
  char* qp = lds + 100352 + tid * 16;
  if constexpr (MODE == 1) {
#pragma unroll
    for (int f = 0; f < 12 - NQR; ++f) *(bf16x8*)(qp + f * 8192) = *(const bf16x8*)(Qw + (NQR + f) * 16);
  }
  const int vb0 = (int)(uintptr_t)V_lds + v_rd_base(lane);
#define RESC(a) do { if constexpr (!FAST) if (__any((a) < 1.f)) { if (hi == 0) al_l[r32] = (a); asm volatile("s_waitcnt lgkmcnt(0)" ::: "memory"); \
    _Pragma("unroll") for (int d = 0; d < 4; ++d) _Pragma("unroll") for (int r = 0; r < 16; ++r) o[d][r] *= al_l[crow(r, hi)]; } } while (0)
  f32x16 pA0, pA1, pB0, pB1; float mnA, mnB, alA, alB; bf16x8 pa0, pa1, pa2, pa3; constexpr int NT = SEQ / KVBLK;
  if (__builtin_amdgcn_readfirstlane(tid) >= 256) __builtin_amdgcn_s_setprio(1);
  if constexpr (MODE == 0) {
    TOPSYNC();
    qkt<MODE, NQR>(pA0, pA1, K_lds, R_lds, qr, qp, r32, hi, kc0); partialSM(pA0, pA1, m_reg, mnA, alA, fast);
    int vpv = 0;
    for (int t = 1; t + 1 < NT; t += 2) {
      SBAR(); qkt<MODE, NQR>(pB0, pB1, K_lds + (t & 3) * SHM_K, R_lds, qr, qp, r32, hi, kc0);
      finishSM(pA0, pA1, alA, l_reg, pa0, pa1, pa2, pa3); SBAR();
      pv_d0(o, vb0 + vpv * SHM_V, pa0, pa1, pa2, pa3); partialSM(pB0, pB1, m_reg, mnB, alB, fast);
      RESC(alB);
      vpv = vpv == 4 ? 0 : vpv + 1;
      TOPSYNC();
      SBAR(); qkt<MODE, NQR>(pA0, pA1, K_lds + ((t + 1) & 3) * SHM_K, R_lds, qr, qp, r32, hi, kc0);
      finishSM(pB0, pB1, alB, l_reg, pa0, pa1, pa2, pa3); SBAR();
      if (t + 3 < NT) { const int v3 = vpv + 3 >= 5 ? vpv - 2 : vpv + 3, v4 = vpv + 4 >= 5 ? vpv - 1 : vpv + 4;
        DMAK1(t + 3, (t + 3) & 3); DMAV1(t + 3, v3); DMAK1(t + 4, (t + 4) & 3); DMAV1(t + 4, v4); } SBAR();
      pv_d0(o, vb0 + vpv * SHM_V, pa0, pa1, pa2, pa3); partialSM(pA0, pA1, m_reg, mnA, alA, fast);
      RESC(alA);
      vpv = vpv == 4 ? 0 : vpv + 1;
    }
    SBAR(); qkt<MODE, NQR>(pB0, pB1, K_lds + ((NT - 1) & 3) * SHM_K, R_lds, qr, qp, r32, hi, kc0);
    finishSM(pA0, pA1, alA, l_reg, pa0, pa1, pa2, pa3); SBAR();
    pv_d0(o, vb0 + vpv * SHM_V, pa0, pa1, pa2, pa3); partialSM(pB0, pB1, m_reg, mnB, alB, fast);
    RESC(alB);
    vpv = vpv == 4 ? 0 : vpv + 1;
    finishSM(pB0, pB1, alB, l_reg, pa0, pa1, pa2, pa3); SBAR();
    pv_d0(o, vb0 + vpv * SHM_V, pa0, pa1, pa2, pa3);
  } else {
  TOPSYNC();
  qkt<MODE, NQR>(pA0, pA1, K_lds, R_lds, qr, qp, r32, hi, kc0); partialSM(pA0, pA1, m_reg, mnA, alA, fast);
  int vpv = 0;
  for (int j = 1; j + 1 < NT; j += 2) {
    TOPSYNC();
    SBAR(); qkt<MODE, NQR>(pB0, pB1, K_lds + SHM_K, R_lds + SHM_R, qr, qp, r32, hi, kc0);
    finishSM(pA0, pA1, alA, l_reg, pa0, pa1, pa2, pa3); SBAR();
    { const int vld = vpv + 2 >= 3 ? vpv - 1 : vpv + 2; DMA(j + 1, 0, vld); } SBAR();
    pv_d0(o, vb0 + vpv * SHM_V, pa0, pa1, pa2, pa3); partialSM(pB0, pB1, m_reg, mnB, alB, fast);
    RESC(alB);
    vpv = vpv == 2 ? 0 : vpv + 1;
    TOPSYNC();
    SBAR(); qkt<MODE, NQR>(pA0, pA1, K_lds, R_lds, qr, qp, r32, hi, kc0);
    finishSM(pB0, pB1, alB, l_reg, pa0, pa1, pa2, pa3); SBAR();
    if (j + 2 < NT) { const int vld = vpv + 2 >= 3 ? vpv - 1 : vpv + 2; DMA(j + 2, 1, vld); } SBAR();
    pv_d0(o, vb0 + vpv * SHM_V, pa0, pa1, pa2, pa3); partialSM(pA0, pA1, m_reg, mnA, alA, fast);
    RESC(alA);
    vpv = vpv == 2 ? 0 : vpv + 1;
  }
  TOPSYNC();
  SBAR(); qkt<MODE, NQR>(pB0, pB1, K_lds + SHM_K, R_lds + SHM_R, qr, qp, r32, hi, kc0);
  finishSM(pA0, pA1, alA, l_reg, pa0, pa1, pa2, pa3); SBAR();
  pv_d0(o, vb0 + vpv * SHM_V, pa0, pa1, pa2, pa3); partialSM(pB0, pB1, m_reg, mnB, alB, fast);
  RESC(alB);
  vpv = vpv == 2 ? 0 : vpv + 1;
  finishSM(pB0, pB1, alB, l_reg, pa0, pa1, pa2, pa3); SBAR();
  pv_d0(o, vb0 + vpv * SHM_V, pa0, pa1, pa2, pa3);
  }
#undef DMAK1
#undef DMAV1
  __builtin_amdgcn_s_setprio(0);
#undef GL
#undef DMA
#undef TOPSYNC
#undef RESC
  if (hi == 0) li_l[r32] = l_reg;
  asm volatile("s_waitcnt lgkmcnt(0)" ::: "memory");
  float rli[16];
#pragma unroll
  for (int r = 0; r < 16; ++r) rli[r] = __builtin_amdgcn_rcpf(li_l[crow(r, hi)]);
  if constexpr (MODE == 1) {
    const unsigned short* zb = (const unsigned short*)(p.ws + OFF_P1) + 704 + h * 128;
    unsigned short* og = (unsigned short*)(p.ws + OFF_H) + h * 128;
#pragma unroll
    for (int r = 0; r < 16; ++r) { const size_t row = tok0 + crow(r, hi);
#pragma unroll
      for (int d0 = 0; d0 < 4; ++d0) { const int col = d0 * 32 + r32;
        const float v = o[d0][r] * rli[r] * bf2f(zb[row * 1792 + col]);
        og[row * 1024 + col] = (unsigned short)(cvtpk(v, v) & 0xffff); } }
  } else {
    const int c = wid & 1, g = wid >> 1;
    float* X = (float*)lds + g * 32 * 128;
    const float lam = *(const float*)(p.ws + OFF_LAM);
    __syncthreads();
    if (c == 1) {
#pragma unroll
      for (int r = 0; r < 16; ++r) { const float s = rli[r] * lam;
#pragma unroll
        for (int d0 = 0; d0 < 4; ++d0) X[crow(r, hi) * 128 + d0 * 32 + r32] = o[d0][r] * s; }
    }
    __syncthreads();
    if (c == 0) {
      const unsigned short* zb = (const unsigned short*)(p.ws + OFF_P0) + 3072 + h * 128;
      unsigned short* og = (unsigned short*)(p.ws + OFF_OG0) + h * 128;
      float gsub[4];
#pragma unroll
      for (int d0 = 0; d0 < 4; ++d0) gsub[d0] = p.subln_g[d0 * 32 + r32] * 0.8f;
#pragma unroll
      for (int r = 0; r < 16; ++r) { const size_t row = tok0 + crow(r, hi);
        float v[4], ss = 0;
#pragma unroll
        for (int d0 = 0; d0 < 4; ++d0) { v[d0] = o[d0][r] * rli[r] - X[crow(r, hi) * 128 + d0 * 32 + r32]; ss += v[d0] * v[d0]; }
        ss += __shfl_xor(ss, 1); ss += __shfl_xor(ss, 2); ss += __shfl_xor(ss, 4); ss += __shfl_xor(ss, 8); ss += __shfl_xor(ss, 16);
        const float rstd = rsqrtf(ss * (1.f / 128.f) + RMS_EPS);
#pragma unroll
        for (int d0 = 0; d0 < 4; ++d0) { const int col = d0 * 32 + r32;
          const float w = v[d0] * rstd * gsub[d0] * bf2f(zb[row * 4096 + col]);
          og[row * 1024 + col] = (unsigned short)(cvtpk(w, w) & 0xffff); } }
    }
    __syncthreads();
  }
}

template <int MODE>
__device__ __forceinline__ void attn_phase(const Params& p, char* lds) {
  constexpr int NTILE = MODE == 0 ? 1024 : 512;
  const int nslot = gridDim.x >> 3, xcd = blockIdx.x & 7, slot = blockIdx.x >> 3;
  bool fast;
  { const int tid = otid(), lane = tid & 63, wid = tid >> 6;
    const float* bq = (const float*)(p.ws + OFF_BND) + (MODE == 0 ? 0 : 2) * 8192; const float* bk = bq + 8192;
    float mq = 0.f, mk = 0.f;
#pragma unroll
    for (int i = 0; i < 16; ++i) { mq = fmaxf(mq, bq[i * 512 + tid]); mk = fmaxf(mk, bk[i * 512 + tid]); }
    for (int o = 32; o >= 1; o >>= 1) { mq = fmaxf(mq, __shfl_xor(mq, o)); mk = fmaxf(mk, __shfl_xor(mk, o)); }
    float* red = (float*)(lds + 98304);
    __syncthreads();
    if (lane == 0) { red[wid] = mq; red[8 + wid] = mk; }
    __syncthreads();
    mq = red[0]; mk = red[8];
#pragma unroll
    for (int i = 1; i < 8; ++i) { mq = fmaxf(mq, red[i]); mk = fmaxf(mk, red[8 + i]); }
    const float bound = (MODE == 0 ? 1.f : 3.f) * sqrtf(mq * mk) * 1.02f;
    fast = bound < 100.f;
    __syncthreads(); }
  for (int s = slot; s < NTILE / 8; s += nslot) {
    const int tile = (xcd + 8 * (s >> 5)) * 32 + (s & 31);
    if (fast) attn_tile<MODE, true>(p, tile, lds); else attn_tile<MODE, false>(p, tile, lds);
  }
}

#define XB_TMO      128
#define XB_XCNT(j)  (256  + 64 * (j))
#define XB_XSUB(j)  (1280 + 64 * (j))
#define XB_XGEN(j)  (2304 + 64 * (j))
#define XB_TOP      3328
#define XB_TOPGEN   3392
#define XCD_BAR_WORDS 3456
#define XB_SPIN_CAP (1u << 22)
#define LAS __attribute__((address_space(3)))
__device__ __forceinline__ unsigned xb_ld(unsigned* p)              { return __hip_atomic_load(p, __ATOMIC_RELAXED, __HIP_MEMORY_SCOPE_AGENT); }
__device__ __forceinline__ unsigned xb_add(unsigned* p, unsigned v) { return __hip_atomic_fetch_add(p, v, __ATOMIC_RELAXED, __HIP_MEMORY_SCOPE_AGENT); }
__device__ __forceinline__ unsigned xb_xcc_id() { return (unsigned)__builtin_amdgcn_s_getreg((3 << 11) | 20) & 0xFu; }
#define XB_SPIN(cond, bar) do { unsigned _sp = 0; while (cond) { __builtin_amdgcn_s_sleep(1); \
    if ((++_sp & 255u) == 0u) { if (xb_ld(&(bar)[XB_TMO])) break; if (_sp > XB_SPIN_CAP) { atomicAdd(&(bar)[XB_TMO], 1u); break; } } } } while (0)
struct XcdBarrier { unsigned* bar; unsigned x; volatile LAS unsigned* st; };
__device__ __forceinline__ XcdBarrier xcd_barrier_post(unsigned* bar, volatile LAS unsigned* st) {
  XcdBarrier b; b.bar = bar; b.x = xb_xcc_id(); b.st = st;
  if (threadIdx.x == 0) (void)xb_add(&bar[XB_XCNT(b.x)], 1u);
  return b;
}
__device__ __forceinline__ void xcd_barrier_complete(unsigned* bar, unsigned x, unsigned& nloc, unsigned& nx) {
  const unsigned G = gridDim.x * gridDim.y * gridDim.z;
  unsigned sum, cnt, mine, sp = 0u;
  for (;;) {
    sum = 0u; cnt = 0u; mine = 0u;
#pragma unroll
    for (unsigned j = 0; j < 16; ++j) { const unsigned c = xb_ld(&bar[XB_XCNT(j)]); sum += c; cnt += (c > 0u) ? 1u : 0u; mine = (j == x) ? c : mine; }
    if (sum == G) break;
    __builtin_amdgcn_s_sleep(1);
    if ((++sp & 255u) == 0u) { if (xb_ld(&bar[XB_TMO])) break; if (sp > XB_SPIN_CAP) { atomicAdd(&bar[XB_TMO], 1u); break; } }
  }
  nloc = mine > 0u ? mine : 1u; nx = cnt > 0u ? cnt : 1u;
}
__device__ __forceinline__ void xcd_barrier(const XcdBarrier& b) {
  asm volatile("s_waitcnt vmcnt(0)" ::: "memory");
  __syncthreads();
  if (threadIdx.x == 0) {
    unsigned* bar = b.bar;
    __builtin_amdgcn_s_waitcnt(0);
    unsigned nloc = b.st[0], nx = b.st[1];
    if (nloc == 0u) { xcd_barrier_complete(bar, b.x, nloc, nx); b.st[0] = nloc; b.st[1] = nx; }
    const unsigned old = xb_add(&bar[XB_XSUB(b.x)], 1u);
    const unsigned gen = old / nloc;
    if (old + 1u == (gen + 1u) * nloc) {
      __builtin_amdgcn_fence(__ATOMIC_RELEASE, "agent");
      asm volatile("s_waitcnt vmcnt(0)" ::: "memory");
      const unsigned og = xb_add(&bar[XB_TOP], 1u);
      const unsigned tg = og / nx;
      if (og + 1u == (tg + 1u) * nx) xb_add(&bar[XB_TOPGEN], 1u);
      else XB_SPIN(xb_ld(&bar[XB_TOPGEN]) == tg, bar);
      __builtin_amdgcn_fence(__ATOMIC_ACQUIRE, "agent");
      xb_add(&bar[XB_XGEN(b.x)], 1u);
      asm volatile("s_waitcnt vmcnt(0)" ::: "memory");
    } else {
      XB_SPIN(xb_ld(&bar[XB_XGEN(b.x)]) == gen, bar);
      __builtin_amdgcn_fence(__ATOMIC_ACQUIRE, "agent");
      asm volatile("s_waitcnt vmcnt(0)" ::: "memory");
    }
  }
  __syncthreads();
}

template <int PH> __device__ __forceinline__ void run_phase(const Params& p, char* lds) {
  const bf16* H = (const bf16*)(p.ws + OFF_H);
  const float* mod = (const float*)(p.ws + OFF_MOD);
  if constexpr (PH == 0) prep_phase(p, lds);
  if constexpr (PH == 1) norm_phase(p.x, p.norm_g0, mod, (bf16*)(p.ws + OFF_H), nullptr);
  if constexpr (PH == 2) gemm_phase(p, G_PROJ0, H, 0, (const bf16*)(p.ws + OFF_WIN0T), 1024, 16, lds);
  if constexpr (PH == 3) attn_phase<0>(p, lds);
  if constexpr (PH == 4) gemm_phase(p, G_OUT0, (const bf16*)(p.ws + OFF_OG0), 1024, (const bf16*)(p.ws + OFF_WOUT0T), 1024, 4, lds);
  if constexpr (PH == 5) norm_phase(p.out, p.norm_g1, mod + 2 * 3072, (bf16*)(p.ws + OFF_H), nullptr);
  if constexpr (PH == 6) gemm_phase(p, G_PROJ1, H, 0, (const bf16*)(p.ws + OFF_WIN1T), 1024, 7, lds);
  if constexpr (PH == 7) { gemm_phase(p, G_Q, (const bf16*)(p.ws + OFF_P1), 1792, (const bf16*)(p.ws + OFF_WQBT), 384, 6, lds);
                           gemm_phase(p, G_KV, (const bf16*)(p.ws + OFF_P1) + 384, 1792, (const bf16*)(p.ws + OFF_WKVBT), 256, 8, lds); }
  if constexpr (PH == 8) attn_phase<1>(p, lds);
  if constexpr (PH == 9) gemm_phase(p, G_OUT1, H, 1024, (const bf16*)(p.ws + OFF_WOUT1T), 1024, 4, lds);
  if constexpr (PH == 10) norm_phase(p.out, p.fin_g, nullptr, nullptr, p.out);
}
template <int PH> __global__ __launch_bounds__(512, 1) void phase_k(Params p) {
  extern __shared__ __attribute__((aligned(16))) char lds[];
  run_phase<PH>(p, lds);
}
__global__ __launch_bounds__(512, 1) void mega(Params p) {
  extern __shared__ __attribute__((aligned(16))) char lds[];
  cg::grid_group grid = cg::this_grid();
  unsigned* bar = (unsigned*)(p.ws + OFF_BAR);
  if (threadIdx.x == 0) { ((unsigned*)(lds + XB_LDS_OFF))[0] = 0u; ((unsigned*)(lds + XB_LDS_OFF))[1] = 0u; }
  if (blockIdx.x == 0) for (int i = threadIdx.x; i < XCD_BAR_WORDS; i += 512) bar[i] = 0u;
  run_phase<0>(p, lds); grid.sync();
  const XcdBarrier xb = xcd_barrier_post(bar, (volatile LAS unsigned*)(lds + XB_LDS_OFF));
  run_phase<1>(p, lds); xcd_barrier(xb);
  run_phase<2>(p, lds); xcd_barrier(xb);
  run_phase<3>(p, lds); xcd_barrier(xb);
  run_phase<4>(p, lds); xcd_barrier(xb);
  run_phase<6>(p, lds); xcd_barrier(xb);
  run_phase<7>(p, lds); xcd_barrier(xb);
  run_phase<8>(p, lds); xcd_barrier(xb);
  run_phase<9>(p, lds);
}
template <int PH> static void launch_phase(const Params& p, int grid, hipStream_t stream) {
  (void)hipFuncSetAttribute((const void*)phase_k<PH>, hipFuncAttributeMaxDynamicSharedMemorySize, LDS_BYTES);
  hipLaunchKernelGGL(phase_k<PH>, dim3(grid), dim3(512), LDS_BYTES, stream, p);
}

extern "C" void kernel_launch(void* const* d_in, const int* in_sizes, int n_in, void* d_out, int out_size, void* d_ws, size_t ws_size, hipStream_t stream) {
  static int grid_blocks = 0;
  if (!grid_blocks) {
    if (ws_size < WS_NEED) { fprintf(stderr, "kernel_launch: ws too small %zu < %zu\n", ws_size, WS_NEED); return; }
    int dev = 0, cus = 0, per_cu = 0;
    (void)hipGetDevice(&dev);
    (void)hipDeviceGetAttribute(&cus, hipDeviceAttributeMultiprocessorCount, dev);
    (void)hipFuncSetAttribute((const void*)mega, hipFuncAttributeMaxDynamicSharedMemorySize, LDS_BYTES);
    (void)hipOccupancyMaxActiveBlocksPerMultiprocessor(&per_cu, mega, 512, LDS_BYTES);
    if (per_cu < 1) { fprintf(stderr, "kernel_launch: occupancy query returned %d\n", per_cu); return; }
    grid_blocks = (cus / 8) * 8;
  }
  Params p{};
  p.x = (const float*)d_in[0]; p.c = (const float*)d_in[1]; p.pos = (const int*)d_in[2];
  p.ada_w0 = (const float*)d_in[3]; p.ada_b0 = (const float*)d_in[4]; p.norm_g0 = (const float*)d_in[5]; p.w_in0 = (const float*)d_in[6];
  p.lq1 = (const float*)d_in[7]; p.lk1 = (const float*)d_in[8]; p.lq2 = (const float*)d_in[9]; p.lk2 = (const float*)d_in[10];
  p.subln_g = (const float*)d_in[11]; p.w_out0 = (const float*)d_in[12];
  p.ada_w1 = (const float*)d_in[13]; p.ada_b1 = (const float*)d_in[14]; p.norm_g1 = (const float*)d_in[15]; p.w_in1 = (const float*)d_in[16];
  p.qa_g = (const float*)d_in[17]; p.w_qb = (const float*)d_in[18]; p.kva_g = (const float*)d_in[19]; p.w_kvb = (const float*)d_in[20];
  p.w_out1 = (const float*)d_in[21]; p.fin_g = (const float*)d_in[22];
  p.out = (float*)d_out; p.ws = (char*)d_ws;
#if MK_COOP
  void* args[] = {&p};
  hipError_t e = hipLaunchCooperativeKernel((const void*)mega, dim3(grid_blocks), dim3(512), args, LDS_BYTES, stream);
  if (e != hipSuccess) fprintf(stderr, "cooperative launch failed: %s (grid %d)\n", hipGetErrorString(e), grid_blocks);
#else
  launch_phase<0>(p, grid_blocks, stream); launch_phase<1>(p, grid_blocks, stream); launch_phase<2>(p, grid_blocks, stream); launch_phase<3>(p, grid_blocks, stream);
  launch_phase<4>(p, grid_blocks, stream); launch_phase<5>(p, grid_blocks, stream); launch_phase<6>(p, grid_blocks, stream); launch_phase<7>(p, grid_blocks, stream);
  launch_phase<8>(p, grid_blocks, stream); launch_phase<9>(p, grid_blocks, stream); launch_phase<10>(p, grid_blocks, stream);
#endif
}
```
